# Optimizing an MI355X kernel written in HIP

```python
import jax, jax.numpy as jnp
from jax import lax
import numpy as np

D_MODEL = 1024
BATCH = 16
SEQ = 2048
DEPTH = 2

CHUNK = 64
NORM_EPS = 1e-6
ROPE_THETA = 10000.0

RWKV_HEADS = 8
RWKV_HEAD_DIM = 64
RWKV_WIDTH = RWKV_HEADS * RWKV_HEAD_DIM
DECAY_LORA = 64
A_LORA = 64
GATE_LORA = 128
GN_EPS = 64e-5
LRU_HEADS = 8
LRU_WIDTH = D_MODEL // 2
LRU_BLOCK = LRU_WIDTH // LRU_HEADS
CONV_WIDTH = 4
LRU_C = 8.0
MIX_WIDTH = RWKV_WIDTH + LRU_WIDTH
RWKV_COLS = (RWKV_WIDTH, RWKV_WIDTH, RWKV_WIDTH, DECAY_LORA, A_LORA, GATE_LORA)
RWKV_PROJ = sum(RWKV_COLS)
IN0_COLS = RWKV_COLS + (LRU_WIDTH, LRU_WIDTH)
IN0_WIDTH = sum(IN0_COLS)

ATT_HEADS = 16
ATT_HEAD_DIM = 64
ATT_WIDTH = ATT_HEADS * ATT_HEAD_DIM
IDX_HEADS = 8
IDX_HEAD_DIM = 64
TOPK_MAX = 256
Q_BLOCK = 128
IN1_COLS = (ATT_WIDTH, ATT_HEAD_DIM, ATT_HEAD_DIM, IDX_HEADS * IDX_HEAD_DIM, IDX_HEAD_DIM, IDX_HEADS)
IN1_WIDTH = sum(IN1_COLS)

FFN_HIDDEN = -(-8 * D_MODEL // (3 * 256)) * 256
N_EVEN = (DEPTH + 1) // 2
N_ODD = DEPTH // 2

kernel_name = 'hybrid_rwkv7_rglru_dsa_encoder'


def split_cols(t, sizes):
    return jnp.split(t, np.cumsum(sizes)[:-1].tolist(), axis=-1)


def rmsnorm(x, g):
    xf = x.astype(jnp.float32)
    y = xf * lax.rsqrt(jnp.mean(xf * xf, axis=-1, keepdims=True) + NORM_EPS)
    return (y * g.astype(jnp.float32)).astype(x.dtype)


def rope_tables(seq, dim):
    inv_freq = ROPE_THETA ** (-jnp.arange(0, dim, 2, dtype=jnp.float32) / dim)
    ang = jnp.arange(seq, dtype=jnp.float32)[:, None] * inv_freq[None, :]
    return jnp.cos(ang), jnp.sin(ang)


def apply_rope(t, cos, sin):
    tf = t.astype(jnp.float32)
    t1, t2 = jnp.split(tf, 2, axis=-1)
    c, s = cos[None, :, None, :], sin[None, :, None, :]
    return jnp.concatenate([t1 * c - t2 * s, t1 * s + t2 * c], axis=-1).astype(t.dtype)


def swiglu(h, w_gate, w_up, w_down):
    return (jax.nn.silu(h @ w_gate) * (h @ w_up)) @ w_down


def token_shift(p, mu):
    prev = jnp.pad(p, ((0, 0), (1, 0), (0, 0)))[:, :-1]
    return p + (prev - p) * mu


def rwkv7_scan(r, decay, k, v, kk, a):
    B, _, H, N = r.shape

    def step(state, inp):
        r_t, w_t, k_t, v_t, kk_t, a_t = inp
        sa = jnp.einsum('bhvk,bhk->bhv', state, -kk_t)
        state = (state * w_t[:, :, None, :]
                 + sa[..., None] * (kk_t * a_t)[:, :, None, :]
                 + v_t[..., None] * k_t[:, :, None, :])
        return state, jnp.einsum('bhvk,bhk->bhv', state, r_t)

    xs = tuple(jnp.moveaxis(t, 1, 0) for t in (r, decay, k, v, kk, a))
    _, ys = lax.scan(step, jnp.zeros((B, H, N, N), jnp.float32), xs)
    return jnp.moveaxis(ys, 0, 1)


def linear_scan_combine(c1, c2):
    a1, b1 = c1
    a2, b2 = c2
    return a1 * a2, a2 * b1 + b2


def rwkv_lru_mixer(h, w_in, mu_shift, w_decay0, w_decay_up, a_bias, w_a_up, w_g_up, k_k, k_a, r_k,
                   lnx_w, lnx_b, conv_w, conv_b, w_rgate, b_rgate, w_igate, b_igate, lru_lambda, w_out):
    B, S, _ = h.shape
    f32 = jnp.float32
    proj = h @ w_in
    rwkv_p, lru_x, lru_gate = split_cols(proj, (RWKV_PROJ, LRU_WIDTH, LRU_WIDTH))

    r, k, v, wd, ad, gd = split_cols(token_shift(rwkv_p, mu_shift), RWKV_COLS)
    heads = lambda t: t.reshape(B, S, RWKV_HEADS, RWKV_HEAD_DIM)
    w_log = -jax.nn.softplus(-(w_decay0 + jnp.tanh(wd) @ w_decay_up).astype(f32)) - 0.5
    decay = jnp.exp(-jnp.exp(w_log))
    a = jax.nn.sigmoid((a_bias + ad @ w_a_up).astype(f32))
    g = jax.nn.sigmoid(gd) @ w_g_up
    rf, kf, vf = r.astype(f32), k.astype(f32), v.astype(f32)
    kk = heads(kf * k_k)
    kk = kk * lax.rsqrt(jnp.maximum(jnp.sum(kk * kk, axis=-1, keepdims=True), 1e-24))
    k_mod = heads(kf * (1.0 + (a - 1.0) * k_a))
    y = rwkv7_scan(heads(rf), heads(decay), k_mod, heads(vf), kk, heads(a))
    y_mean = jnp.mean(y, axis=-1, keepdims=True)
    y_var = jnp.mean(jnp.square(y - y_mean), axis=-1, keepdims=True)
    y = ((y - y_mean) * lax.rsqrt(y_var + GN_EPS)).reshape(B, S, RWKV_WIDTH) * lnx_w + lnx_b
    bonus = jnp.sum(heads(rf) * k_mod * r_k, axis=-1, keepdims=True) * heads(vf)
    rwkv_out = (y + bonus.reshape(B, S, RWKV_WIDTH)) * g

    xpad = jnp.pad(lru_x, ((0, 0), (CONV_WIDTH - 1, 0), (0, 0)))
    xc = conv_b + xpad[:, 0:S] * conv_w[0]
    for j in range(1, CONV_WIDTH):
        xc = xc + xpad[:, j:j + S] * conv_w[j]
    xh = xc.reshape(B, S, LRU_HEADS, LRU_BLOCK)
    rg = jax.nn.sigmoid((jnp.einsum('bshi,hij->bshj', xh, w_rgate) + b_rgate).astype(f32))
    ig = jax.nn.sigmoid((jnp.einsum('bshi,hij->bshj', xh, w_igate) + b_igate).astype(f32))
    log_a = -LRU_C * rg * jax.nn.softplus(-lru_lambda.astype(f32)).reshape(LRU_HEADS, LRU_BLOCK)
    a_t = jnp.exp(log_a)
    x_in = xh.astype(f32) * ig * jnp.sqrt(-jnp.expm1(2.0 * log_a))
    _, hs = lax.associative_scan(linear_scan_combine, (a_t, x_in), axis=1)
    lru_out = hs.reshape(B, S, LRU_WIDTH) * jax.nn.gelu(lru_gate.astype(f32))

    mixed = jnp.concatenate([rwkv_out, lru_out], axis=-1).astype(h.dtype)
    return mixed @ w_out


def dsa_mixer(h, w_in, w_out, cos, sin):
    B, S, _ = h.shape
    topk = min(TOPK_MAX, S // 4)
    n_blocks = S // Q_BLOCK
    q, k, v, iq, ik, iw = split_cols(h @ w_in, IN1_COLS)
    q = apply_rope(q.reshape(B, S, ATT_HEADS, ATT_HEAD_DIM), cos, sin)
    k = apply_rope(k.reshape(B, S, 1, ATT_HEAD_DIM), cos, sin)[:, :, 0]
    iq = apply_rope(iq.reshape(B, S, IDX_HEADS, IDX_HEAD_DIM), cos, sin)
    ik = apply_rope(ik.reshape(B, S, 1, IDX_HEAD_DIM), cos, sin)[:, :, 0].astype(jnp.float32)
    iw = iw.astype(jnp.float32) * IDX_HEADS ** -0.5
    key_chunk = jnp.arange(S) // CHUNK

    def to_blocks(t):
        return jnp.swapaxes(t.reshape((B, n_blocks, Q_BLOCK) + t.shape[2:]), 0, 1)

    def block(args):
        qb, iqb, iwb, bi = args
        q_chunk = (bi * Q_BLOCK + jnp.arange(Q_BLOCK)) // CHUNK
        admissible = key_chunk[None, :] <= q_chunk[:, None]
        idx_logits = jnp.einsum('bqhd,bsd->bqhs', iqb.astype(jnp.float32), ik) * IDX_HEAD_DIM ** -0.5
        score = jnp.einsum('bqh,bqhs->bqs', iwb, jax.nn.relu(idx_logits))
        score = jnp.where(admissible[None], score, -jnp.inf)
        _, sel = lax.top_k(score, topk)
        valid = (sel // CHUNK) <= q_chunk[None, :, None]
        k_sel = jax.vmap(lambda kb, ib: kb[ib])(k, sel)
        v_sel = jax.vmap(lambda vb, ib: vb[ib])(v, sel)
        logits = jnp.einsum('bqhd,bqkd->bqhk', qb, k_sel).astype(jnp.float32) * ATT_HEAD_DIM ** -0.5
        logits = jnp.where(valid[:, :, None, :], logits, -jnp.inf)
        probs = jax.nn.softmax(logits, axis=-1).astype(v_sel.dtype)
        return jnp.einsum('bqhk,bqkd->bqhd', probs, v_sel)

    out = lax.map(block, (to_blocks(q), to_blocks(iq), to_blocks(iw), jnp.arange(n_blocks)))
    out = jnp.swapaxes(out, 0, 1).reshape(B, S, ATT_WIDTH)
    return out @ w_out


def setup_inputs(seed: int = 0) -> dict:
    key = jax.random.key(seed)
    ks = iter(jax.random.split(key, 32))
    nrm = lambda shape, scale: scale * jax.random.normal(next(ks), shape, jnp.float32)
    uni = lambda shape, lo, hi: jax.random.uniform(next(ks), shape, jnp.float32, lo, hi)
    D, E, O = D_MODEL, N_EVEN, N_ODD
    a_pow_c = uni((E, LRU_WIDTH), 0.9, 0.999)
    a_base = a_pow_c ** (1.0 / LRU_C)
    lru_lambda = jnp.log(a_base) - jnp.log1p(-a_base)
    return {
        'x': nrm((BATCH, SEQ, D), 1.0),
        'norm_mix': 1.0 + nrm((DEPTH, D), 0.02),
        'w_in0': nrm((E, D, IN0_WIDTH), D ** -0.5),
        'mu_shift': uni((E, RWKV_PROJ), 0.0, 1.0),
        'w_decay0': uni((E, RWKV_WIDTH), -6.0, -1.0),
        'w_decay_up': nrm((E, DECAY_LORA, RWKV_WIDTH), 0.1 * DECAY_LORA ** -0.5),
        'a_bias': nrm((E, RWKV_WIDTH), 0.5),
        'w_a_up': nrm((E, A_LORA, RWKV_WIDTH), 0.5 * A_LORA ** -0.5),
        'w_g_up': nrm((E, GATE_LORA, RWKV_WIDTH), GATE_LORA ** -0.5),
        'k_k': 0.85 + nrm((E, RWKV_WIDTH), 0.02),
        'k_a': 1.0 + nrm((E, RWKV_WIDTH), 0.02),
        'r_k': nrm((E, RWKV_HEADS, RWKV_HEAD_DIM), 0.1),
        'lnx_w': 1.0 + nrm((E, RWKV_WIDTH), 0.02),
        'lnx_b': nrm((E, RWKV_WIDTH), 0.02),
        'conv_w': nrm((E, CONV_WIDTH, LRU_WIDTH), CONV_WIDTH ** -0.5),
        'conv_b': nrm((E, LRU_WIDTH), 0.02),
        'w_rgate': nrm((E, LRU_HEADS, LRU_BLOCK, LRU_BLOCK), LRU_BLOCK ** -0.5),
        'b_rgate': nrm((E, LRU_HEADS, LRU_BLOCK), 0.02),
        'w_igate': nrm((E, LRU_HEADS, LRU_BLOCK, LRU_BLOCK), LRU_BLOCK ** -0.5),
        'b_igate': nrm((E, LRU_HEADS, LRU_BLOCK), 0.02),
        'lru_lambda': lru_lambda,
        'w_out0': nrm((E, MIX_WIDTH, D), MIX_WIDTH ** -0.5),
        'w_in1': nrm((O, D, IN1_WIDTH), D ** -0.5),
        'w_out1': nrm((O, ATT_WIDTH, D), ATT_WIDTH ** -0.5),
        'norm_ffn': 1.0 + nrm((DEPTH, D), 0.02),
        'ffn_gate': nrm((DEPTH, D, FFN_HIDDEN), D ** -0.5),
        'ffn_up': nrm((DEPTH, D, FFN_HIDDEN), D ** -0.5),
        'ffn_down': nrm((DEPTH, FFN_HIDDEN, D), FFN_HIDDEN ** -0.5),
        'norm_final': 1.0 + nrm((D,), 0.02),
    }


def reference(x, norm_mix, w_in0, mu_shift, w_decay0, w_decay_up, a_bias, w_a_up, w_g_up, k_k, k_a, r_k,
              lnx_w, lnx_b, conv_w, conv_b, w_rgate, b_rgate, w_igate, b_igate, lru_lambda, w_out0,
              w_in1, w_out1, norm_ffn, ffn_gate, ffn_up, ffn_down, norm_final):
    cos, sin = rope_tables(x.shape[1], ATT_HEAD_DIM)
    for layer in range(DEPTH):
        h = rmsnorm(x, norm_mix[layer])
        if layer % 2 == 0:
            e = layer // 2
            x = x + rwkv_lru_mixer(h, w_in0[e], mu_shift[e], w_decay0[e], w_decay_up[e], a_bias[e],
                                   w_a_up[e], w_g_up[e], k_k[e], k_a[e], r_k[e], lnx_w[e], lnx_b[e],
                                   conv_w[e], conv_b[e], w_rgate[e], b_rgate[e], w_igate[e], b_igate[e],
                                   lru_lambda[e], w_out0[e])
        else:
            o = layer // 2
            x = x + dsa_mixer(h, w_in1[o], w_out1[o], cos, sin)
        h = rmsnorm(x, norm_ffn[layer])
        x = x + swiglu(h, ffn_gate[layer], ffn_up[layer], ffn_down[layer])
    return rmsnorm(x, norm_final)
```

```cpp
#include <hip/hip_runtime.h>
#include <cstdio>
#include <cstdint>
namespace pg8 {
#define PG8_LAS __attribute__((address_space(3)))
typedef unsigned short bf16_t;
typedef short bf16x8 __attribute__((ext_vector_type(8)));
typedef float f32x4 __attribute__((ext_vector_type(4)));
typedef unsigned u32x4 __attribute__((ext_vector_type(4)));
constexpr int BM = 256, BK = 64, HALF = 128, HTB = HALF * BK * 2  , STAGE_BYTES = 8 * HTB, NXCD = 8, WGM = 8;

__host__ __device__ __forceinline__ int lds_byte(int r, int c) { const int st = (r >> 4) * 2 + (c >> 5), rr = r & 15, cc = c & 31, ob = rr * 64 + cc * 2; return st * 1024 + (ob ^ (((ob >> 9) & 1) << 5)); }
__host__ __device__ __forceinline__ void stage_rc(int b, int& R, int& C) { const int st = b / 1024, sb = b % 1024, swz = sb ^ (((sb >> 9) & 1) << 5); R = (st >> 1) * 16 + swz / 64; C = (st & 1) * 32 + (swz % 64) / 2; }
__host__ __device__ __forceinline__ int perm32(int rho) { const int n = rho >> 4, i = rho & 15; return 8 * (i >> 2) + 4 * n + (i & 3); }

struct Unit { int pm, pn; };
struct Gemm { const bf16_t* A; const bf16_t* Bt; int M, N, K; };

struct StaticOrder {
    int nM, nN, nwg, G, c;
    __host__ __device__ void init(int M, int N, int G_, int c_) { nM = M / BM; nN = N / BM; nwg = nM * nN; G = G_; c = c_; }
    __host__ __device__ bool next(int i, Unit& u) const {
        const long L = (long)i * G + c; if (L >= nwg) return false;
        int wgid = (int)L; { const int q = nwg / NXCD, r = nwg % NXCD, xcd = wgid % NXCD, off = wgid / NXCD; wgid = (xcd < r ? xcd * (q + 1) : r * (q + 1) + (xcd - r) * q) + off; }
        const int nig = WGM * nN, gid = wgid / nig, fm = gid * WGM, gsz = (nM - fm) < WGM ? (nM - fm) : WGM;
        u.pm = fm + ((wgid % nig) % gsz); u.pn = (wgid % nig) / gsz; return true;
    }
    __device__ __forceinline__ void a_ready(const Unit&) const {}
    __device__ __forceinline__ void done(const Unit&) const {}
};
__device__ __forceinline__ unsigned cvt_pk_bf16(float lo, float hi) { unsigned r; asm volatile("v_cvt_pk_bf16_f32 %0, %1, %2" : "=v"(r) : "v"(lo), "v"(hi)); return r; }
template <class Epi, class Sched, bool ALIGN_EPI = false, bool SP2 = false>
__device__ __forceinline__ void gemm_phase(PG8_LAS unsigned char* lds, const Gemm g, const Sched& S, const Epi& E) {
    const int tid = threadIdx.x, wid = __builtin_amdgcn_readfirstlane(tid >> 6), lane = tid & 63, wr = wid >> 2, wc = wid & 3, fr = lane & 15, fq = lane >> 4;
    const int K = g.K, nt = K / BK;
    unsigned voffA[2], voffB[2];
#pragma unroll
    for (int i = 0; i < 2; ++i) { int R, C; stage_rc(tid * 16 + i * 8192, R, C); const int Rb = Epi::PERM ? ((R & ~31) + perm32(R & 31)) : R;
        voffA[i] = (unsigned)(R * K + C) * 2u; voffB[i] = (unsigned)(Rb * K + C) * 2u; }
    const size_t kstep = (size_t)(BK * 2);
    const size_t hstep = (size_t)HALF * K * 2;
    const size_t tstep = 2 * hstep;
    const unsigned ldsw = (unsigned)wid * 1024u;
    const int aoff = lds_byte(wr * 64 + fr, fq * 8), boff = lds_byte(wc * 32 + fr, fq * 8);
#define PG8_SA(b, h) (((b) * 2 + (h)) * HTB)
#define PG8_SB(b, h) ((4 + (b) * 2 + (h)) * HTB)
#define PG8_STAGE(bufoff, gbase, voff) do { _Pragma("unroll") for (int _i = 0; _i < 2; ++_i) \
        __builtin_amdgcn_global_load_lds((const unsigned*)((const char*)(gbase) + (voff)[_i]), (PG8_LAS unsigned*)(lds + (bufoff) + ldsw + _i * 8192), 16, 0, 0); } while (0)
#define PG8_LDA(dst, b, h) do { _Pragma("unroll") for (int m = 0; m < 4; ++m) _Pragma("unroll") for (int k = 0; k < 2; ++k) dst[m][k] = *(const PG8_LAS bf16x8*)(lds + PG8_SA(b, h) + aoff + m * 2048 + k * 1024); } while (0)
#define PG8_LDB(dst, b, h) do { _Pragma("unroll") for (int n = 0; n < 2; ++n) _Pragma("unroll") for (int k = 0; k < 2; ++k) dst[n][k] = *(const PG8_LAS bf16x8*)(lds + PG8_SB(b, h) + boff + n * 2048 + k * 1024); } while (0)
#define PG8_MMA(ai, bj, At, Bt) do { __builtin_amdgcn_s_setprio(1); _Pragma("unroll") for (int m = 0; m < 4; ++m) _Pragma("unroll") for (int n = 0; n < 2; ++n) _Pragma("unroll") for (int k = 0; k < 2; ++k) \
        acc[ai][bj][m][n] = __builtin_amdgcn_mfma_f32_16x16x32_bf16(Bt[n][k], At[m][k], acc[ai][bj][m][n], 0, 0, 0); __builtin_amdgcn_s_setprio(0); } while (0)
#define PG8_WAIT_V(n) asm volatile("s_waitcnt vmcnt(" #n ")" ::: "memory")
#define PG8_WAIT_L(n) asm volatile("s_waitcnt lgkmcnt(" #n ")" ::: "memory")
#define PG8_BAR __builtin_amdgcn_s_barrier()
#define PG8_SCHED __builtin_amdgcn_sched_barrier(0)
    Unit cur, nxt; int ui = 0;
    if (!S.next(0, cur)) return;
    f32x4 acc[2][2][4][2];
#pragma unroll
    for (int a = 0; a < 2; ++a)
#pragma unroll
        for (int b = 0; b < 2; ++b)
#pragma unroll
            for (int m = 0; m < 4; ++m)
#pragma unroll
                for (int n = 0; n < 2; ++n) acc[a][b][m][n] = (f32x4){0.f, 0.f, 0.f, 0.f};
    bf16x8 At[4][2], B0[2][2], B1[2][2];
    const char* cA = (const char*)g.A + (size_t)cur.pm * tstep; const char* cB = (const char*)g.Bt + (size_t)cur.pn * tstep;
    S.a_ready(cur);
    if constexpr (SP2) {
        PG8_STAGE(PG8_SB(0, 0), cB, voffB); PG8_STAGE(PG8_SB(0, 1), cB + hstep, voffB); PG8_STAGE(PG8_SA(0, 0), cA, voffA); PG8_STAGE(PG8_SA(0, 1), cA + hstep, voffA);
        if (wr == 1) PG8_BAR;
        PG8_WAIT_V(2); PG8_BAR;
        PG8_STAGE(PG8_SB(1, 0), cB + kstep, voffB); PG8_STAGE(PG8_SA(1, 0), cA + kstep, voffA); PG8_STAGE(PG8_SB(1, 1), cB + hstep + kstep, voffB);
        PG8_WAIT_V(6); PG8_BAR;
    } else {
        PG8_STAGE(PG8_SB(0, 0), cB, voffB); PG8_STAGE(PG8_SA(0, 0), cA, voffA); PG8_STAGE(PG8_SB(0, 1), cB + hstep, voffB); PG8_STAGE(PG8_SA(0, 1), cA + hstep, voffA);
        if (wr == 1) PG8_BAR;
        PG8_WAIT_V(4); PG8_BAR;
        PG8_STAGE(PG8_SB(1, 0), cB + kstep, voffB); PG8_STAGE(PG8_SA(1, 0), cA + kstep, voffA); PG8_STAGE(PG8_SB(1, 1), cB + hstep + kstep, voffB);
        PG8_WAIT_V(6); PG8_BAR;
    }
    for (;;) {
        const bool has_next = S.next(ui + 1, nxt);
        const char* nA = has_next ? (const char*)g.A + (size_t)nxt.pm * tstep : cA; const char* nB = has_next ? (const char*)g.Bt + (size_t)nxt.pn * tstep : cB;
        for (int t = 0; t < nt; t += 2) {
            const bool last = (t == nt - 2);
            const char* a1 = cA + (size_t)(t + 1) * kstep;
            const char* a2 = last ? nA : cA + (size_t)(t + 2) * kstep; const char* b2 = last ? nB : cB + (size_t)(t + 2) * kstep;
            const char* a3 = a2 + kstep; const char* b3 = b2 + kstep;
            if (last && has_next) S.a_ready(nxt);
            if constexpr (SP2) {
            PG8_LDB(B0, 0, 0); PG8_LDB(B1, 0, 1); PG8_SCHED; PG8_LDA(At, 0, 0); PG8_STAGE(PG8_SA(1, 1), a1 + hstep, voffA);
            PG8_WAIT_V(8); PG8_WAIT_L(0); PG8_BAR; PG8_MMA(0, 0, At, B0); PG8_MMA(0, 1, At, B1); PG8_BAR; PG8_SCHED;
            PG8_LDA(At, 0, 1); PG8_STAGE(PG8_SB(0, 0), b2, voffB); PG8_STAGE(PG8_SB(0, 1), b2 + hstep, voffB); PG8_STAGE(PG8_SA(0, 0), a2, voffA);
            PG8_WAIT_V(8); PG8_WAIT_L(0); PG8_BAR; PG8_MMA(1, 0, At, B0); PG8_MMA(1, 1, At, B1); PG8_BAR; PG8_SCHED;
            PG8_LDB(B0, 1, 0); PG8_LDB(B1, 1, 1); PG8_SCHED; PG8_LDA(At, 1, 0); PG8_STAGE(PG8_SA(0, 1), a2 + hstep, voffA);
            PG8_WAIT_V(8); PG8_WAIT_L(0); PG8_BAR; PG8_MMA(0, 0, At, B0); PG8_MMA(0, 1, At, B1); PG8_BAR; PG8_SCHED;
            PG8_LDA(At, 1, 1); PG8_STAGE(PG8_SB(1, 0), b3, voffB); PG8_STAGE(PG8_SB(1, 1), b3 + hstep, voffB); PG8_STAGE(PG8_SA(1, 0), a3, voffA);
            PG8_WAIT_V(8); PG8_WAIT_L(0); PG8_BAR; PG8_MMA(1, 0, At, B0); PG8_MMA(1, 1, At, B1); PG8_BAR; PG8_SCHED;
            } else {
            PG8_LDB(B0, 0, 0); PG8_SCHED; PG8_LDA(At, 0, 0); PG8_STAGE(PG8_SA(1, 1), a1 + hstep, voffA);
            PG8_WAIT_L(8); PG8_BAR; PG8_WAIT_L(0); PG8_MMA(0, 0, At, B0); PG8_BAR; PG8_SCHED;
            PG8_LDB(B1, 0, 1); PG8_STAGE(PG8_SB(0, 0), b2, voffB);
            PG8_BAR; PG8_WAIT_L(0); PG8_MMA(0, 1, At, B1); PG8_BAR;
            PG8_LDA(At, 0, 1); PG8_STAGE(PG8_SA(0, 0), a2, voffA);
            PG8_BAR; PG8_WAIT_L(0); PG8_MMA(1, 0, At, B0); PG8_BAR; PG8_SCHED;
            PG8_STAGE(PG8_SB(0, 1), b2 + hstep, voffB);
            PG8_WAIT_V(6); PG8_BAR; PG8_MMA(1, 1, At, B1); PG8_BAR;
            PG8_LDB(B0, 1, 0); PG8_SCHED; PG8_LDA(At, 1, 0); PG8_STAGE(PG8_SA(0, 1), a2 + hstep, voffA);
            PG8_WAIT_L(8); PG8_BAR; PG8_WAIT_L(0); PG8_MMA(0, 0, At, B0); PG8_BAR; PG8_SCHED;
            PG8_LDB(B1, 1, 1); PG8_STAGE(PG8_SB(1, 0), b3, voffB);
            PG8_BAR; PG8_WAIT_L(0); PG8_MMA(0, 1, At, B1); PG8_BAR;
            PG8_LDA(At, 1, 1); PG8_STAGE(PG8_SA(1, 0), a3, voffA);
            PG8_BAR; PG8_WAIT_L(0); PG8_MMA(1, 0, At, B0); PG8_BAR; PG8_SCHED;
            PG8_STAGE(PG8_SB(1, 1), b3 + hstep, voffB);
            PG8_WAIT_V(6); PG8_BAR; PG8_MMA(1, 1, At, B1); PG8_BAR;
            }
        }
        if constexpr (ALIGN_EPI) { if (wr == 0) PG8_BAR; }
        if constexpr (!Epi::AFTER_DRAIN) { E(acc, cur, wr, wc, fr, fq); S.done(cur); }
        if (!has_next) break;
#pragma unroll
        for (int a = 0; a < 2; ++a)
#pragma unroll
            for (int b = 0; b < 2; ++b)
#pragma unroll
                for (int m = 0; m < 4; ++m)
#pragma unroll
                    for (int n = 0; n < 2; ++n) acc[a][b][m][n] = (f32x4){0.f, 0.f, 0.f, 0.f};
        cur = nxt; cA = nA; cB = nB; ++ui;
        if constexpr (ALIGN_EPI) { if (wr == 1) PG8_BAR; }
    }
    PG8_WAIT_V(0);
    if constexpr (!ALIGN_EPI) { if (wr == 0) PG8_BAR; }
    PG8_BAR;
    if constexpr (Epi::AFTER_DRAIN) { E.fused(acc, cur, wr, wc, fr, fq, lds, wid, lane); S.done(cur); }
#undef PG8_SA
#undef PG8_SB
#undef PG8_STAGE
#undef PG8_LDA
#undef PG8_LDB
#undef PG8_MMA
#undef PG8_WAIT_V
#undef PG8_WAIT_L
#undef PG8_BAR
#undef PG8_SCHED
}
}
#define GAS __attribute__((address_space(1)))
#define LAS __attribute__((address_space(3)))
typedef unsigned short bf16;
typedef unsigned v4u __attribute__((ext_vector_type(4)));
typedef float f32x4 __attribute__((ext_vector_type(4)));
typedef short bf16x8 __attribute__((ext_vector_type(8)));
typedef GAS unsigned gu32;
typedef GAS unsigned long long gu64;
#define RLX_AGENT __ATOMIC_RELAXED, __HIP_MEMORY_SCOPE_AGENT
#define LDS_WAIT() asm volatile("s_waitcnt lgkmcnt(0)" ::: "memory")
#define VM_WAIT() asm volatile("s_waitcnt vmcnt(0)" ::: "memory")
__device__ __forceinline__ unsigned long long rt() { return __builtin_amdgcn_s_memrealtime(); }
__device__ __forceinline__ unsigned f2bf(float f) { unsigned u = __builtin_bit_cast(unsigned, f); return (u + 0x7fffu + ((u >> 16) & 1u)) >> 16; }
__device__ __forceinline__ unsigned pk2(float lo, float hi) { return f2bf(lo) | (f2bf(hi) << 16); }

#define XB_TMO      128
#define XB_XCNT(j)  (256  + 64 * (j))
#define XB_XSUB(j)  (1280 + 64 * (j))
#define XB_XGEN(j)  (2304 + 64 * (j))
#define XB_TOP      3328
#define XB_TOPGEN   3392
#define XCD_BAR_WORDS 3456
#define XB_SPIN_CAP (1u << 18)

__device__ __forceinline__ unsigned xb_ld(unsigned* p)              { return __hip_atomic_load(p, __ATOMIC_RELAXED, __HIP_MEMORY_SCOPE_AGENT); }
__device__ __forceinline__ unsigned xb_add(unsigned* p, unsigned v) { return __hip_atomic_fetch_add(p, v, __ATOMIC_RELAXED, __HIP_MEMORY_SCOPE_AGENT); }
__device__ __forceinline__ unsigned xb_xcc_id() { return (unsigned)__builtin_amdgcn_s_getreg((3 << 11) | 20) & 0xFu; }
#define XB_SPIN(cond, bar) do { unsigned _sp = 0; while (cond) { __builtin_amdgcn_s_sleep(1); \
    if ((++_sp & 255u) == 0u) { if (xb_ld(&(bar)[XB_TMO])) break; if (_sp > XB_SPIN_CAP) { atomicAdd(&(bar)[XB_TMO], 1u); break; } } } } while (0)

struct XcdBarrier {
    unsigned* bar; unsigned x;
    volatile LAS unsigned* st;
};

__device__ __forceinline__ XcdBarrier xcd_barrier_post(unsigned* bar, volatile LAS unsigned* st) {
    XcdBarrier b; b.bar = bar; b.x = xb_xcc_id(); b.st = st;
    if (threadIdx.x == 0) (void)xb_add(&bar[XB_XCNT(b.x)], 1u);
    return b;
}
__device__ __forceinline__ void xcd_barrier_complete(unsigned* bar, unsigned x, unsigned& nloc, unsigned& nx) {
    const unsigned G = gridDim.x * gridDim.y * gridDim.z;
    unsigned sum, cnt, mine, sp = 0u;
    for (;;) {
        sum = 0u; cnt = 0u; mine = 0u;
#pragma unroll
        for (unsigned j = 0; j < 16; ++j) { const unsigned c = xb_ld(&bar[XB_XCNT(j)]); sum += c; cnt += (c > 0u) ? 1u : 0u; mine = (j == x) ? c : mine; }
        if (sum == G) break;
        __builtin_amdgcn_s_sleep(1);
        if ((++sp & 255u) == 0u) { if (xb_ld(&bar[XB_TMO])) break; if (sp > XB_SPIN_CAP) { atomicAdd(&bar[XB_TMO], 1u); break; } }
    }
    nloc = mine > 0u ? mine : 1u; nx = cnt > 0u ? cnt : 1u;
}

__device__ __forceinline__ void xcd_barrier(const XcdBarrier& b) {
    asm volatile("s_waitcnt vmcnt(0)" ::: "memory");
    __syncthreads();
    if (threadIdx.x == 0) {
        unsigned* bar = b.bar;
        __builtin_amdgcn_s_waitcnt(0);
        unsigned nloc = b.st[0], nx = b.st[1];
        if (nloc == 0u) { xcd_barrier_complete(bar, b.x, nloc, nx); b.st[0] = nloc; b.st[1] = nx; }
        const unsigned old = xb_add(&bar[XB_XSUB(b.x)], 1u);
        const unsigned gen = old / nloc;
        if (old + 1u == (gen + 1u) * nloc) {
            __builtin_amdgcn_fence(__ATOMIC_RELEASE, "agent");
            asm volatile("s_waitcnt vmcnt(0)" ::: "memory");
            const unsigned og = xb_add(&bar[XB_TOP], 1u);
            const unsigned tg = og / nx;
            if (og + 1u == (tg + 1u) * nx) xb_add(&bar[XB_TOPGEN], 1u);
            else XB_SPIN(xb_ld(&bar[XB_TOPGEN]) == tg, bar);
            __builtin_amdgcn_fence(__ATOMIC_ACQUIRE, "agent");
            xb_add(&bar[XB_XGEN(b.x)], 1u);
            asm volatile("s_waitcnt vmcnt(0)" ::: "memory");
        } else {
            XB_SPIN(xb_ld(&bar[XB_XGEN(b.x)]) == gen, bar);
            __builtin_amdgcn_fence(__ATOMIC_ACQUIRE, "agent");
            asm volatile("s_waitcnt vmcnt(0)" ::: "memory");
        }
    }
    __syncthreads();
}

constexpr int NWAVES = 8;
constexpr int BATCH = 16, SEQ = 2048, DM = 1024, MTOK = BATCH * SEQ;
constexpr int IN0 = 2816, FFH = 2816, IN1 = 1736, IN1P = 1792, RWKVW = 512, LRUW = 512;
constexpr float NORM_EPS = 1e-6f, GN_EPS = 64e-5f;
constexpr int C_R = 0, C_K = 512, C_V = 1024, C_WD = 1536, C_LX = 1792, C_LG = 2304;

constexpr size_t MiB = 1u << 20;
constexpr size_t WS_CTL = 0, CTL_ZERO_BYTES = 64 * 1024;
constexpr size_t WS_W_IN0T = 1 * MiB, WS_W_OUT0T = 7 * MiB, WS_W_GU0T = 9 * MiB, WS_W_DN0T = 20 * MiB, WS_W_IN1T = 26 * MiB, WS_W_OUT1T = 30 * MiB,
                 WS_W_GU1T = 32 * MiB, WS_W_DN1T = 43 * MiB, WS_W_LORAT = 49 * MiB, WS_W_GATET = 50 * MiB, WS_ROPE = 51 * MiB, WS_SSQ = 52 * MiB;
constexpr size_t WS_XB = 64 * MiB, WS_R1 = 128 * MiB, WS_R2 = 304 * MiB, WS_END = 480 * MiB;
constexpr size_t WS_DECAY = WS_R2, WS_LRUA = WS_R2 + 64 * MiB, WS_AARR = WS_R2 + 128 * MiB, WS_ALORA = WS_R2 + 160 * MiB;
constexpr size_t DO_G = 0, DO_XC = 32 * MiB, DO_KK = 64 * MiB, DO_LRUX = 96 * MiB;
constexpr size_t WS_Q = WS_R2, WS_IQ = WS_R2 + 64 * MiB, WS_KR = WS_R2 + 96 * MiB, WS_VT = WS_R2 + 100 * MiB, WS_IK = WS_R2 + 104 * MiB, WS_IW = WS_R2 + 108 * MiB;
constexpr int CW_BAR = 1024;

constexpr int RING_OFF = 0, RING_BYTES = 131072;
constexpr int LDSCTL_OFF = RING_BYTES, MISC_OFF = LDSCTL_OFF + 320;
constexpr int LDS_BYTES = 147456;

typedef unsigned u32x2 __attribute__((ext_vector_type(2)));
typedef unsigned short u16x4 __attribute__((ext_vector_type(4)));
typedef unsigned short u16x8 __attribute__((ext_vector_type(8)));
typedef float f32x2 __attribute__((ext_vector_type(2)));

__device__ __forceinline__ float bf2f(unsigned b) { return __builtin_bit_cast(float, b << 16); }
__device__ __forceinline__ float bflo(unsigned w) { return __builtin_bit_cast(float, w << 16); }
__device__ __forceinline__ float bfhi(unsigned w) { return __builtin_bit_cast(float, w & 0xffff0000u); }
__device__ __forceinline__ unsigned pkbf(float lo, float hi) { return pg8::cvt_pk_bf16(lo, hi); }
__device__ __forceinline__ float sigmoidf_(float x) { return 1.0f / (1.0f + __expf(-x)); }
__device__ __forceinline__ float softplusf_(float u) { return fmaxf(u, 0.f) + __logf(1.0f + __expf(-fabsf(u))); }
__device__ __forceinline__ float one_minus_exp(float x) { return x > -0.02f ? -x * (1.0f + x * (0.5f + x * (0.16666667f + x * 0.041666668f))) : 1.0f - __expf(x); }
__device__ __forceinline__ float tanhf_(float x) { const float e = __expf(-2.0f * fabsf(x)); const float t = (1.0f - e) / (1.0f + e); return x < 0.f ? -t : t; }
__device__ __forceinline__ float gelu_tanh(float x) { const float u = 0.7978845608028654f * (x + 0.044715f * x * x * x); return 0.5f * x * (1.0f + tanhf_(u)); }
__device__ __forceinline__ float row_rstd(const float* ssq, int row) {
    const f32x4* p = (const f32x4*)(ssq + (size_t)row * 16);
    const f32x4 a = p[0], b = p[1], c = p[2], d = p[3];
    const float s = (((a[0] + a[1]) + (a[2] + a[3])) + ((b[0] + b[1]) + (b[2] + b[3]))) + (((c[0] + c[1]) + (c[2] + c[3])) + ((d[0] + d[1]) + (d[2] + d[3])));
    return rsqrtf(s * (1.0f / 1024.0f) + NORM_EPS);
}

using pg8::Unit;
struct EpiScaleBf16 {
    static constexpr bool PERM = true, AFTER_DRAIN = false;
    bf16* O; int ldc; const float* ssq;
    __device__ __forceinline__ void operator()(const f32x4 (&acc)[2][2][4][2], const Unit& u, int wr, int wc, int fr, int fq) const {
        const int row0 = u.pm * 256 + wr * 64 + fr, col0 = u.pn * 256 + wc * 32 + 8 * fq;
#pragma unroll
        for (int ai = 0; ai < 2; ++ai)
#pragma unroll
            for (int m = 0; m < 4; ++m) { const int row = row0 + ai * 128 + m * 16; const float rs = row_rstd(ssq, row); bf16* rowp = O + (size_t)row * ldc + col0;
#pragma unroll
                for (int bj = 0; bj < 2; ++bj) { const f32x4 v0 = acc[ai][bj][m][0] * rs, v1 = acc[ai][bj][m][1] * rs;
                    v4u w; w.x = pkbf(v0[0], v0[1]); w.y = pkbf(v0[2], v0[3]); w.z = pkbf(v1[0], v1[1]); w.w = pkbf(v1[2], v1[3]);
                    *(v4u*)(rowp + bj * 128) = w; } }
    }
};
struct EpiSwiglu {
    static constexpr bool PERM = true, AFTER_DRAIN = false;
    bf16* O; const float* ssq;
    __device__ __forceinline__ void operator()(const f32x4 (&acc)[2][2][4][2], const Unit& u, int wr, int wc, int fr, int fq) const {
        const int row0 = u.pm * 256 + wr * 64 + fr, col0 = u.pn * 128 + wc * 32 + 8 * fq;
#pragma unroll
        for (int ai = 0; ai < 2; ++ai)
#pragma unroll
            for (int m = 0; m < 4; ++m) { const int row = row0 + ai * 128 + m * 16; const float rs = row_rstd(ssq, row);
                float a[8];
#pragma unroll
                for (int n = 0; n < 2; ++n)
#pragma unroll
                    for (int e = 0; e < 4; ++e) { const float g = acc[ai][0][m][n][e] * rs, up = acc[ai][1][m][n][e] * rs; a[n * 4 + e] = g * __builtin_amdgcn_rcpf(1.0f + __expf(-g)) * up; }
                v4u w; w.x = pkbf(a[0], a[1]); w.y = pkbf(a[2], a[3]); w.z = pkbf(a[4], a[5]); w.w = pkbf(a[6], a[7]);
                *(v4u*)(O + (size_t)row * FFH + col0) = w; }
    }
};
struct EpiResid {
    static constexpr bool PERM = false, AFTER_DRAIN = false;
    const float* resid; float* out; bf16* xb; float* ssq;
    __device__ __forceinline__ void operator()(const f32x4 (&acc)[2][2][4][2], const Unit& u, int wr, int wc, int fr, int fq) const {
        const int row0 = u.pm * 256 + wr * 64 + fr, colb = u.pn * 256 + wc * 32 + 4 * fq;
#pragma unroll
        for (int ai = 0; ai < 2; ++ai)
#pragma unroll
            for (int m = 0; m < 4; ++m) { const int row = row0 + ai * 128 + m * 16; const size_t off = (size_t)row * DM + colb; float ss = 0.f;
#pragma unroll
                for (int bj = 0; bj < 2; ++bj)
#pragma unroll
                    for (int n = 0; n < 2; ++n) { const size_t o2 = off + bj * 128 + n * 16;
                        const f32x4 o = *(const f32x4*)(resid + o2) + acc[ai][bj][m][n];
                        *(f32x4*)(out + o2) = o;
                        if (xb) { u32x2 w; w.x = pkbf(o[0], o[1]); w.y = pkbf(o[2], o[3]); *(u32x2*)(xb + o2) = w; }
                        ss += (o[0] * o[0] + o[1] * o[1]) + (o[2] * o[2] + o[3] * o[3]); }
                ss += __shfl_xor(ss, 16); ss += __shfl_xor(ss, 32);
                if (fq == 0) ssq[(size_t)row * 16 + u.pn * 4 + wc] = ss; }
    }
};
template <int TYPE> struct EpiLora {
    static constexpr bool PERM = false, AFTER_DRAIN = false;
    const float* bias_; float* decay; bf16* ob;
    __device__ __forceinline__ void operator()(const f32x4 (&acc)[2][2][4][2], const Unit& u, int wr, int wc, int fr, int fq) const {
        const int row0 = u.pm * 256 + wr * 64 + fr, cb = u.pn * 256 + wc * 32 + 4 * fq;
#pragma unroll
        for (int bj = 0; bj < 2; ++bj)
#pragma unroll
            for (int n = 0; n < 2; ++n) { const int c = cb + bj * 128 + n * 16;
                f32x4 bias = (f32x4){0.f, 0.f, 0.f, 0.f};
                if (TYPE != 2) bias = *(const f32x4*)(bias_ + c);
#pragma unroll
                for (int ai = 0; ai < 2; ++ai)
#pragma unroll
                    for (int m = 0; m < 4; ++m) { const int row = row0 + ai * 128 + m * 16; const f32x4 z = acc[ai][bj][m][n] + bias; const size_t o = (size_t)row * 512 + c;
                        if (TYPE == 0) { f32x4 d;
#pragma unroll
                            for (int e = 0; e < 4; ++e) { const float wl = -softplusf_(-z[e]) - 0.5f; d[e] = __expf(-__expf(wl)); }
                            *(f32x4*)(decay + o) = d;
                        } else if (TYPE == 1) { u32x2 w; w.x = pkbf(sigmoidf_(z[0]), sigmoidf_(z[1])); w.y = pkbf(sigmoidf_(z[2]), sigmoidf_(z[3])); *(u32x2*)(ob + o) = w;
                        } else { u32x2 w; w.x = pkbf(z[0], z[1]); w.y = pkbf(z[2], z[3]); *(u32x2*)(ob + o) = w; } } }
    }
};
struct EpiGate {
    static constexpr bool PERM = false, AFTER_DRAIN = false;
    const float* b_r; const float* b_i; const float* lam; const bf16* xc; float* lrua; bf16* lrux;
    __device__ __forceinline__ void operator()(const f32x4 (&acc)[2][2][4][2], const Unit& u, int wr, int wc, int fr, int fq) const {
        const int row0 = u.pm * 256 + wr * 64 + fr;
#pragma unroll
        for (int n = 0; n < 2; ++n) { const int c = u.pn * 128 + wc * 32 + n * 16 + 4 * fq;
            const f32x4 br = *(const f32x4*)(b_r + c), bi = *(const f32x4*)(b_i + c), lm = *(const f32x4*)(lam + c);
            f32x4 sp;
#pragma unroll
            for (int e = 0; e < 4; ++e) sp[e] = -8.0f * softplusf_(-lm[e]);
#pragma unroll
            for (int ai = 0; ai < 2; ++ai)
#pragma unroll
                for (int m = 0; m < 4; ++m) { const int row = row0 + ai * 128 + m * 16; const size_t o = (size_t)row * 512 + c;
                    const u32x2 xw = *(const u32x2*)(xc + o); const float xv[4] = {bflo(xw.x), bfhi(xw.x), bflo(xw.y), bfhi(xw.y)};
                    f32x4 av; float xi[4];
#pragma unroll
                    for (int e = 0; e < 4; ++e) { const float rg = sigmoidf_(acc[ai][0][m][n][e] + br[e]), ig = sigmoidf_(acc[ai][1][m][n][e] + bi[e]);
                        const float la = rg * sp[e]; av[e] = __expf(la); xi[e] = xv[e] * ig * sqrtf(fmaxf(one_minus_exp(2.0f * la), 0.f)); }
                    *(f32x4*)(lrua + o) = av; u32x2 w; w.x = pkbf(xi[0], xi[1]); w.y = pkbf(xi[2], xi[3]); *(u32x2*)(lrux + o) = w;
                    asm volatile("" ::: "memory"); } }
    }
};
struct EpiProj1 {
    static constexpr bool PERM = false, AFTER_DRAIN = false;
    const float* ssq; const float* ropec; const float* ropes; bf16 *Q, *KR, *VT, *IQ, *IK; float* IW;
    template <int BJ> __device__ __forceinline__ void half(const f32x4 (&acc)[2][2][4][2], const Unit& u, int wr, int wc, int fr, int fq) const {
        const int row0 = u.pm * 256 + wr * 64 + fr;
        const int pc = u.pn * 256 + BJ * 128 + wc * 32, gi = pc >> 6, w = (pc >> 5) & 1;
        const bool rope = (gi <= 16) || (gi >= 18 && gi <= 26);
#pragma unroll
        for (int ai = 0; ai < 2; ++ai)
#pragma unroll
            for (int m = 0; m < 4; ++m) { const int row = row0 + ai * 128 + m * 16; const float rs = row_rstd(ssq, row); const int t = row & (SEQ - 1), b = row >> 11;
                const f32x4 x0 = acc[ai][BJ][m][0] * rs, x1 = acc[ai][BJ][m][1] * rs;
                if (rope) { const int d = 16 * w + 4 * fq;
                    const f32x4 cs = *(const f32x4*)(ropec + t * 32 + d), sn = *(const f32x4*)(ropes + t * 32 + d);
                    f32x4 o1 = x0 * cs - x1 * sn, o2 = x0 * sn + x1 * cs; bf16* dst;
                    if (gi < 16) { dst = Q + (size_t)row * 1024 + gi * 64; o1 = o1 * 0.125f; o2 = o2 * 0.125f; }
                    else if (gi == 16) dst = KR + (size_t)row * 64;
                    else if (gi < 26) { dst = IQ + (size_t)row * 512 + (gi - 18) * 64; o1 = o1 * 0.125f; o2 = o2 * 0.125f; }
                    else dst = IK + (size_t)row * 64;
                    u32x2 w1, w2; w1.x = pkbf(o1[0], o1[1]); w1.y = pkbf(o1[2], o1[3]); w2.x = pkbf(o2[0], o2[1]); w2.y = pkbf(o2[2], o2[3]);
                    *(u32x2*)(dst + d) = w1; *(u32x2*)(dst + d + 32) = w2;
                } else if (gi == 17) { const int d0 = 32 * w + 4 * fq; bf16* vb = VT + (size_t)b * 64 * SEQ + t;
#pragma unroll
                    for (int e = 0; e < 4; ++e) { vb[(size_t)(d0 + e) * SEQ] = (bf16)(pkbf(x0[e], 0.f) & 0xffffu); vb[(size_t)(d0 + 16 + e) * SEQ] = (bf16)(pkbf(x1[e], 0.f) & 0xffffu); }
                } else if (gi == 27) { if (w == 0 && fq < 2) *(f32x4*)(IW + (size_t)row * 8 + 4 * fq) = x0 * 0.35355339059327373f; } }
    }
    __device__ __forceinline__ void operator()(const f32x4 (&acc)[2][2][4][2], const Unit& u, int wr, int wc, int fr, int fq) const {
        half<0>(acc, u, wr, wc, fr, fq); half<1>(acc, u, wr, wc, fr, fq);
    }
};

struct Ctx {
    LAS unsigned char* lds;
    int tid, lane, wave, vcu, G;
    const float* const* in; float* out; unsigned char* ws;
};
enum { I_X = 0, I_NORM_MIX, I_W_IN0, I_MU, I_W_DECAY0, I_W_DECAY_UP, I_A_BIAS, I_W_A_UP, I_W_G_UP, I_K_K, I_K_A, I_R_K, I_LNX_W, I_LNX_B, I_CONV_W, I_CONV_B,
       I_W_RGATE, I_B_RGATE, I_W_IGATE, I_B_IGATE, I_LAMBDA, I_W_OUT0, I_W_IN1, I_W_OUT1, I_NORM_FFN, I_FFN_GATE, I_FFN_UP, I_FFN_DOWN, I_NORM_FINAL };

__device__ __forceinline__ float wave_sum(float v) {
#pragma unroll
    for (int o = 1; o < 64; o <<= 1) v += __shfl_xor(v, o);
    return v;
}

enum { MAP_ID = 0, MAP_GATE = 1, MAP_UP = 2, MAP_IN1 = 3 };
__device__ __forceinline__ int map_row(int mode, int n) {
    if (mode == MAP_GATE) return (n >> 7) * 256 + (n & 127);
    if (mode == MAP_UP) return (n >> 7) * 256 + 128 + (n & 127);
    if (mode == MAP_IN1) { const int gi = n >> 6, d = n & 63; const bool rope = (gi <= 16) || (gi >= 18 && gi <= 26);
        if (!rope) return n;
        const int ph = d < 32 ? ((d >> 4) * 32 + (d & 15)) : (((d - 32) >> 4) * 32 + 16 + ((d - 32) & 15));
        return gi * 64 + ph; }
    return n;
}
__device__ __forceinline__ void p0_transpose_item(const float* W, int K, int N, int Npad, const float* gain, bf16* WT, int mode, LAS float* scr, int item, int lane) {
    const int nblk = Npad >> 5, kb = item / nblk, nb = item - kb * nblk, k0 = 64 * kb, n0 = 32 * nb;
    const int ncol = n0 + (lane & 31); const bool cin = ncol < N;
#pragma unroll 8
    for (int i = 0; i < 32; ++i) { const int kk = 2 * i + (lane >> 5); float v = cin ? W[(size_t)(k0 + kk) * N + ncol] : 0.f; if (gain) v *= gain[k0 + kk]; scr[kk * 33 + (lane & 31)] = v; }
    LDS_WAIT(); asm volatile("" ::: "memory");
    const int c = lane & 7;
#pragma unroll
    for (int j = 0; j < 4; ++j) { const int n = (lane >> 3) + 8 * j; const LAS float* s = scr + (8 * c) * 33 + n;
        v4u o; o.x = pkbf(s[0 * 33], s[1 * 33]); o.y = pkbf(s[2 * 33], s[3 * 33]); o.z = pkbf(s[4 * 33], s[5 * 33]); o.w = pkbf(s[6 * 33], s[7 * 33]);
        *(v4u*)(WT + (size_t)map_row(mode, n0 + n) * K + k0 + 8 * c) = o; }
    LDS_WAIT(); asm volatile("" ::: "memory");
}
__device__ __forceinline__ void p0_prologue(const Ctx& F) {
    LAS float* scr = (LAS float*)(F.lds + RING_OFF + F.wave * 16384);
    const int gw = F.vcu * NWAVES + F.wave, NGW = F.G * NWAVES;
    unsigned char* ws = F.ws;
    constexpr int I_A = 16 * 88, I_B = 16 * 32, I_D = 44 * 32, I_C = 16 * 56;
    constexpr int NITEMS = 7 * I_A + 2 * I_B + I_C;
    static_assert(I_A == I_D, "item counts");
    for (int it = gw; it < NITEMS; it += NGW) {
        int r = it;
        if (r < I_A) { p0_transpose_item(F.in[I_W_IN0], 1024, IN0, IN0, F.in[I_NORM_MIX], (bf16*)(ws + WS_W_IN0T), MAP_ID, scr, r, F.lane); continue; } r -= I_A;
        if (r < I_B) { p0_transpose_item(F.in[I_W_OUT0], 1024, 1024, 1024, nullptr, (bf16*)(ws + WS_W_OUT0T), MAP_ID, scr, r, F.lane); continue; } r -= I_B;
        if (r < I_A) { p0_transpose_item(F.in[I_FFN_GATE], 1024, FFH, FFH, F.in[I_NORM_FFN], (bf16*)(ws + WS_W_GU0T), MAP_GATE, scr, r, F.lane); continue; } r -= I_A;
        if (r < I_A) { p0_transpose_item(F.in[I_FFN_UP], 1024, FFH, FFH, F.in[I_NORM_FFN], (bf16*)(ws + WS_W_GU0T), MAP_UP, scr, r, F.lane); continue; } r -= I_A;
        if (r < I_D) { p0_transpose_item(F.in[I_FFN_DOWN], FFH, 1024, 1024, nullptr, (bf16*)(ws + WS_W_DN0T), MAP_ID, scr, r, F.lane); continue; } r -= I_D;
        if (r < I_C) { p0_transpose_item(F.in[I_W_IN1], 1024, IN1, IN1P, F.in[I_NORM_MIX] + 1024, (bf16*)(ws + WS_W_IN1T), MAP_IN1, scr, r, F.lane); continue; } r -= I_C;
        if (r < I_B) { p0_transpose_item(F.in[I_W_OUT1], 1024, 1024, 1024, nullptr, (bf16*)(ws + WS_W_OUT1T), MAP_ID, scr, r, F.lane); continue; } r -= I_B;
        if (r < I_A) { p0_transpose_item(F.in[I_FFN_GATE] + (size_t)1024 * FFH, 1024, FFH, FFH, F.in[I_NORM_FFN] + 1024, (bf16*)(ws + WS_W_GU1T), MAP_GATE, scr, r, F.lane); continue; } r -= I_A;
        if (r < I_A) { p0_transpose_item(F.in[I_FFN_UP] + (size_t)1024 * FFH, 1024, FFH, FFH, F.in[I_NORM_FFN] + 1024, (bf16*)(ws + WS_W_GU1T), MAP_UP, scr, r, F.lane); continue; } r -= I_A;
        p0_transpose_item(F.in[I_FFN_DOWN] + (size_t)FFH * 1024, FFH, 1024, 1024, nullptr, (bf16*)(ws + WS_W_DN1T), MAP_ID, scr, r, F.lane);
    }
    const int gt = F.vcu * (NWAVES * 64) + F.tid, NGT = F.G * NWAVES * 64;
    { bf16* L = (bf16*)(ws + WS_W_LORAT);
      for (int i = gt; i < 1536 * 256; i += NGT) { const int n = i >> 8, k = i & 255; float v = 0.f;
          if (n < 512) { if (k < 64) v = F.in[I_W_DECAY_UP][k * 512 + n]; }
          else if (n < 1024) { if (k >= 64 && k < 128) v = F.in[I_W_A_UP][(k - 64) * 512 + (n - 512)]; }
          else { if (k >= 128) v = F.in[I_W_G_UP][(k - 128) * 512 + (n - 1024)]; }
          L[i] = (bf16)(pkbf(v, 0.f) & 0xffffu); } }
    { bf16* Gt = (bf16*)(ws + WS_W_GATET);
      for (int i = gt; i < 1024 * 512; i += NGT) { const int n = i >> 9, k = i & 511; const int j = n >> 8, isI = (n >> 7) & 1, ch = 128 * j + (n & 127), h = ch >> 6, jj = ch & 63; float v = 0.f;
          if ((k >> 6) == h) v = (isI ? F.in[I_W_IGATE] : F.in[I_W_RGATE])[h * 4096 + (k & 63) * 64 + jj];
          Gt[i] = (bf16)(pkbf(v, 0.f) & 0xffffu); } }
    { float* rc = (float*)(ws + WS_ROPE); float* rsn = rc + SEQ * 32;
      for (int i = gt; i < SEQ * 32; i += NGT) { const int t = i >> 5, f = i & 31; const float invf = (float)pow(10000.0, -(double)f / 32.0); const float ang = (float)t * invf;
          rc[i] = (float)cos((double)ang); rsn[i] = (float)sin((double)ang); } }
    { bf16* XB = (bf16*)(ws + WS_XB); float* ssq = (float*)(ws + WS_SSQ); const float* x = F.in[I_X];
      for (int m = gw; m < MTOK; m += NGW) { const f32x4* xr = (const f32x4*)(x + (size_t)m * DM) + F.lane; f32x4 v[4]; float s = 0.f;
#pragma unroll
          for (int j = 0; j < 4; ++j) { v[j] = xr[64 * j]; s += (v[j][0] * v[j][0] + v[j][1] * v[j][1]) + (v[j][2] * v[j][2] + v[j][3] * v[j][3]); }
          s = wave_sum(s);
          u32x2* o8 = (u32x2*)(XB + (size_t)m * DM) + F.lane;
#pragma unroll
          for (int j = 0; j < 4; ++j) { u32x2 w; w.x = pkbf(v[j][0], v[j][1]); w.y = pkbf(v[j][2], v[j][3]); o8[64 * j] = w; }
          if (F.lane < 16) ssq[(size_t)m * 16 + F.lane] = (F.lane == 0) ? s : 0.f; } }
}

__device__ __forceinline__ void p2a_prep(const Ctx& F) {
    const int gw = F.vcu * NWAVES + F.wave, NGW = F.G * NWAVES, lane = F.lane;
    const bf16* PROJ = (const bf16*)(F.ws + WS_R1);
    bf16* ALORA = (bf16*)(F.ws + WS_ALORA); bf16* KK = (bf16*)((unsigned char*)F.out + DO_KK); bf16* XC = (bf16*)((unsigned char*)F.out + DO_XC);
    const float* mu = F.in[I_MU];
    float mu_l[4], mu_k[8], kkc[8], cw[4][8], cb[8];
#pragma unroll
    for (int e = 0; e < 4; ++e) mu_l[e] = mu[C_WD + 4 * lane + e];
#pragma unroll
    for (int e = 0; e < 8; ++e) { mu_k[e] = mu[C_K + 8 * lane + e]; kkc[e] = F.in[I_K_K][8 * lane + e]; cb[e] = F.in[I_CONV_B][8 * lane + e];
#pragma unroll
        for (int j = 0; j < 4; ++j) cw[j][e] = F.in[I_CONV_W][j * 512 + 8 * lane + e]; }
    for (int m = gw; m < MTOK; m += NGW) { const int t = m & (SEQ - 1); const bf16* p = PROJ + (size_t)m * IN0;
        { const u32x2 cur = *(const u32x2*)(p + C_WD + 4 * lane); u32x2 prv = (u32x2){0u, 0u}; if (t > 0) prv = *(const u32x2*)(p - IN0 + C_WD + 4 * lane);
          const float xc_[4] = {bflo(cur.x), bfhi(cur.x), bflo(cur.y), bfhi(cur.y)}, xp_[4] = {bflo(prv.x), bfhi(prv.x), bflo(prv.y), bfhi(prv.y)}; float o[4];
#pragma unroll
          for (int e = 0; e < 4; ++e) { const float s = xc_[e] + (xp_[e] - xc_[e]) * mu_l[e]; o[e] = lane < 16 ? tanhf_(s) : (lane < 32 ? s : sigmoidf_(s)); }
          u32x2 w; w.x = pkbf(o[0], o[1]); w.y = pkbf(o[2], o[3]); *(u32x2*)(ALORA + (size_t)m * 256 + 4 * lane) = w; }
        { const v4u cur = *(const v4u*)(p + C_K + 8 * lane); v4u prv = (v4u){0u, 0u, 0u, 0u}; if (t > 0) prv = *(const v4u*)(p - IN0 + C_K + 8 * lane);
          const unsigned cw_[4] = {cur.x, cur.y, cur.z, cur.w}, pw_[4] = {prv.x, prv.y, prv.z, prv.w}; float kr[8]; float ss = 0.f;
#pragma unroll
          for (int e = 0; e < 8; ++e) { const float xc_ = (e & 1) ? bfhi(cw_[e >> 1]) : bflo(cw_[e >> 1]), xp_ = (e & 1) ? bfhi(pw_[e >> 1]) : bflo(pw_[e >> 1]);
              kr[e] = (xc_ + (xp_ - xc_) * mu_k[e]) * kkc[e]; ss += kr[e] * kr[e]; }
          ss += __shfl_xor(ss, 1); ss += __shfl_xor(ss, 2); ss += __shfl_xor(ss, 4);
          const float inv = rsqrtf(fmaxf(ss, 1e-24f));
          v4u w; w.x = pkbf(kr[0] * inv, kr[1] * inv); w.y = pkbf(kr[2] * inv, kr[3] * inv); w.z = pkbf(kr[4] * inv, kr[5] * inv); w.w = pkbf(kr[6] * inv, kr[7] * inv);
          *(v4u*)(KK + (size_t)m * 512 + 8 * lane) = w; }
        { float a[8];
#pragma unroll
          for (int e = 0; e < 8; ++e) a[e] = cb[e];
#pragma unroll
          for (int j = 0; j < 4; ++j) { const int tt = t - 3 + j; if (tt >= 0) { const v4u x = *(const v4u*)(p + (ptrdiff_t)(j - 3) * IN0 + C_LX + 8 * lane); const unsigned xw[4] = {x.x, x.y, x.z, x.w};
#pragma unroll
                  for (int e = 0; e < 8; ++e) a[e] += cw[j][e] * ((e & 1) ? bfhi(xw[e >> 1]) : bflo(xw[e >> 1])); } }
          v4u w; w.x = pkbf(a[0], a[1]); w.y = pkbf(a[2], a[3]); w.z = pkbf(a[4], a[5]); w.w = pkbf(a[6], a[7]);
          *(v4u*)(XC + (size_t)m * 512 + 8 * lane) = w; }
    }
}
__device__ __forceinline__ void rwkv_dot16(float& o0, float& o1, const float (&s)[16], float vec) {
    asm volatile("s_nop 1\n\t"
        "v_mul_f32_dpp %0, %18, %2 row_newbcast:0 row_mask:0xf bank_mask:0xf\n\t"
        "v_mul_f32_dpp %1, %18, %3 row_newbcast:1 row_mask:0xf bank_mask:0xf\n\t"
        "v_fmac_f32_dpp %0, %18, %4 row_newbcast:2 row_mask:0xf bank_mask:0xf\n\t"
        "v_fmac_f32_dpp %1, %18, %5 row_newbcast:3 row_mask:0xf bank_mask:0xf\n\t"
        "v_fmac_f32_dpp %0, %18, %6 row_newbcast:4 row_mask:0xf bank_mask:0xf\n\t"
        "v_fmac_f32_dpp %1, %18, %7 row_newbcast:5 row_mask:0xf bank_mask:0xf\n\t"
        "v_fmac_f32_dpp %0, %18, %8 row_newbcast:6 row_mask:0xf bank_mask:0xf\n\t"
        "v_fmac_f32_dpp %1, %18, %9 row_newbcast:7 row_mask:0xf bank_mask:0xf\n\t"
        "v_fmac_f32_dpp %0, %18, %10 row_newbcast:8 row_mask:0xf bank_mask:0xf\n\t"
        "v_fmac_f32_dpp %1, %18, %11 row_newbcast:9 row_mask:0xf bank_mask:0xf\n\t"
        "v_fmac_f32_dpp %0, %18, %12 row_newbcast:10 row_mask:0xf bank_mask:0xf\n\t"
        "v_fmac_f32_dpp %1, %18, %13 row_newbcast:11 row_mask:0xf bank_mask:0xf\n\t"
        "v_fmac_f32_dpp %0, %18, %14 row_newbcast:12 row_mask:0xf bank_mask:0xf\n\t"
        "v_fmac_f32_dpp %1, %18, %15 row_newbcast:13 row_mask:0xf bank_mask:0xf\n\t"
        "v_fmac_f32_dpp %0, %18, %16 row_newbcast:14 row_mask:0xf bank_mask:0xf\n\t"
        "v_fmac_f32_dpp %1, %18, %17 row_newbcast:15 row_mask:0xf bank_mask:0xf\n\t"
        : "=&v"(o0), "=&v"(o1)
        : "v"(s[0]), "v"(s[1]), "v"(s[2]), "v"(s[3]), "v"(s[4]), "v"(s[5]), "v"(s[6]), "v"(s[7]), "v"(s[8]), "v"(s[9]), "v"(s[10]), "v"(s[11]), "v"(s[12]), "v"(s[13]), "v"(s[14]), "v"(s[15]), "v"(vec));
}
__device__ __forceinline__ void rwkv_update0(float (&s)[16], float w, float kka, float kmod, float sa, float vs) {
    asm volatile("s_nop 1\n\t"
        "v_mul_f32_dpp %0, %8, %0 row_newbcast:0 row_mask:0xf bank_mask:0xf\n\t"
        "v_mul_f32_dpp %1, %8, %1 row_newbcast:1 row_mask:0xf bank_mask:0xf\n\t"
        "v_mul_f32_dpp %2, %8, %2 row_newbcast:2 row_mask:0xf bank_mask:0xf\n\t"
        "v_mul_f32_dpp %3, %8, %3 row_newbcast:3 row_mask:0xf bank_mask:0xf\n\t"
        "v_mul_f32_dpp %4, %8, %4 row_newbcast:4 row_mask:0xf bank_mask:0xf\n\t"
        "v_mul_f32_dpp %5, %8, %5 row_newbcast:5 row_mask:0xf bank_mask:0xf\n\t"
        "v_mul_f32_dpp %6, %8, %6 row_newbcast:6 row_mask:0xf bank_mask:0xf\n\t"
        "v_mul_f32_dpp %7, %8, %7 row_newbcast:7 row_mask:0xf bank_mask:0xf\n\t"
        "v_fmac_f32_dpp %0, %9, %11 row_newbcast:0 row_mask:0xf bank_mask:0xf\n\t"
        "v_fmac_f32_dpp %1, %9, %11 row_newbcast:1 row_mask:0xf bank_mask:0xf\n\t"
        "v_fmac_f32_dpp %2, %9, %11 row_newbcast:2 row_mask:0xf bank_mask:0xf\n\t"
        "v_fmac_f32_dpp %3, %9, %11 row_newbcast:3 row_mask:0xf bank_mask:0xf\n\t"
        "v_fmac_f32_dpp %4, %9, %11 row_newbcast:4 row_mask:0xf bank_mask:0xf\n\t"
        "v_fmac_f32_dpp %5, %9, %11 row_newbcast:5 row_mask:0xf bank_mask:0xf\n\t"
        "v_fmac_f32_dpp %6, %9, %11 row_newbcast:6 row_mask:0xf bank_mask:0xf\n\t"
        "v_fmac_f32_dpp %7, %9, %11 row_newbcast:7 row_mask:0xf bank_mask:0xf\n\t"
        "v_fmac_f32_dpp %0, %10, %12 row_newbcast:0 row_mask:0xf bank_mask:0xf\n\t"
        "v_fmac_f32_dpp %1, %10, %12 row_newbcast:1 row_mask:0xf bank_mask:0xf\n\t"
        "v_fmac_f32_dpp %2, %10, %12 row_newbcast:2 row_mask:0xf bank_mask:0xf\n\t"
        "v_fmac_f32_dpp %3, %10, %12 row_newbcast:3 row_mask:0xf bank_mask:0xf\n\t"
        "v_fmac_f32_dpp %4, %10, %12 row_newbcast:4 row_mask:0xf bank_mask:0xf\n\t"
        "v_fmac_f32_dpp %5, %10, %12 row_newbcast:5 row_mask:0xf bank_mask:0xf\n\t"
        "v_fmac_f32_dpp %6, %10, %12 row_newbcast:6 row_mask:0xf bank_mask:0xf\n\t"
        "v_fmac_f32_dpp %7, %10, %12 row_newbcast:7 row_mask:0xf bank_mask:0xf\n\t"
        : "+v"(s[0]), "+v"(s[1]), "+v"(s[2]), "+v"(s[3]), "+v"(s[4]), "+v"(s[5]), "+v"(s[6]), "+v"(s[7])
        : "v"(w), "v"(kka), "v"(kmod), "v"(sa), "v"(vs));
}
__device__ __forceinline__ void rwkv_update1(float (&s)[16], float w, float kka, float kmod, float sa, float vs) {
    asm volatile("s_nop 1\n\t"
        "v_mul_f32_dpp %0, %8, %0 row_newbcast:8 row_mask:0xf bank_mask:0xf\n\t"
        "v_mul_f32_dpp %1, %8, %1 row_newbcast:9 row_mask:0xf bank_mask:0xf\n\t"
        "v_mul_f32_dpp %2, %8, %2 row_newbcast:10 row_mask:0xf bank_mask:0xf\n\t"
        "v_mul_f32_dpp %3, %8, %3 row_newbcast:11 row_mask:0xf bank_mask:0xf\n\t"
        "v_mul_f32_dpp %4, %8, %4 row_newbcast:12 row_mask:0xf bank_mask:0xf\n\t"
        "v_mul_f32_dpp %5, %8, %5 row_newbcast:13 row_mask:0xf bank_mask:0xf\n\t"
        "v_mul_f32_dpp %6, %8, %6 row_newbcast:14 row_mask:0xf bank_mask:0xf\n\t"
        "v_mul_f32_dpp %7, %8, %7 row_newbcast:15 row_mask:0xf bank_mask:0xf\n\t"
        "v_fmac_f32_dpp %0, %9, %11 row_newbcast:8 row_mask:0xf bank_mask:0xf\n\t"
        "v_fmac_f32_dpp %1, %9, %11 row_newbcast:9 row_mask:0xf bank_mask:0xf\n\t"
        "v_fmac_f32_dpp %2, %9, %11 row_newbcast:10 row_mask:0xf bank_mask:0xf\n\t"
        "v_fmac_f32_dpp %3, %9, %11 row_newbcast:11 row_mask:0xf bank_mask:0xf\n\t"
        "v_fmac_f32_dpp %4, %9, %11 row_newbcast:12 row_mask:0xf bank_mask:0xf\n\t"
        "v_fmac_f32_dpp %5, %9, %11 row_newbcast:13 row_mask:0xf bank_mask:0xf\n\t"
        "v_fmac_f32_dpp %6, %9, %11 row_newbcast:14 row_mask:0xf bank_mask:0xf\n\t"
        "v_fmac_f32_dpp %7, %9, %11 row_newbcast:15 row_mask:0xf bank_mask:0xf\n\t"
        "v_fmac_f32_dpp %0, %10, %12 row_newbcast:8 row_mask:0xf bank_mask:0xf\n\t"
        "v_fmac_f32_dpp %1, %10, %12 row_newbcast:9 row_mask:0xf bank_mask:0xf\n\t"
        "v_fmac_f32_dpp %2, %10, %12 row_newbcast:10 row_mask:0xf bank_mask:0xf\n\t"
        "v_fmac_f32_dpp %3, %10, %12 row_newbcast:11 row_mask:0xf bank_mask:0xf\n\t"
        "v_fmac_f32_dpp %4, %10, %12 row_newbcast:12 row_mask:0xf bank_mask:0xf\n\t"
        "v_fmac_f32_dpp %5, %10, %12 row_newbcast:13 row_mask:0xf bank_mask:0xf\n\t"
        "v_fmac_f32_dpp %6, %10, %12 row_newbcast:14 row_mask:0xf bank_mask:0xf\n\t"
        "v_fmac_f32_dpp %7, %10, %12 row_newbcast:15 row_mask:0xf bank_mask:0xf\n\t"
        : "+v"(s[8]), "+v"(s[9]), "+v"(s[10]), "+v"(s[11]), "+v"(s[12]), "+v"(s[13]), "+v"(s[14]), "+v"(s[15])
        : "v"(w), "v"(kka), "v"(kmod), "v"(sa), "v"(vs));
}

__device__ __forceinline__ float allreduce_rows(float x) {
    const unsigned xi = __builtin_bit_cast(unsigned, x);
    const auto r = __builtin_amdgcn_permlane32_swap(xi, xi, false, false);
    const float y = __builtin_bit_cast(float, (unsigned)r[0]) + __builtin_bit_cast(float, (unsigned)r[1]);
    const unsigned yi = __builtin_bit_cast(unsigned, y);
    const auto q = __builtin_amdgcn_permlane16_swap(yi, yi, false, false);
    return __builtin_bit_cast(float, (unsigned)q[0]) + __builtin_bit_cast(float, (unsigned)q[1]);
}

__device__ __forceinline__ void rwkv_scan_wave(const Ctx& F, int bh, int rq) {
    const int lane = F.lane, b = bh >> 3, h = bh & 7, rl = lane & 15;
    const bf16* PROJ = (const bf16*)(F.ws + WS_R1) + (size_t)b * SEQ * IN0;
    const float* DEC = (const float*)(F.ws + WS_DECAY) + (size_t)b * SEQ * 512 + h * 64 + lane;
    const bf16* AA = (const bf16*)(F.ws + WS_AARR) + (size_t)b * SEQ * 512 + h * 64 + lane;
    const bf16* KKp = (const bf16*)((const unsigned char*)F.out + DO_KK) + (size_t)b * SEQ * 512 + h * 64 + lane;
    bf16* Y = (bf16*)(F.ws + WS_XB) + (size_t)b * SEQ * 1024 + h * 64 + rq * 16 + rl;
    const bf16* pr_ = PROJ + C_R + h * 64 + lane; const bf16* pk_ = PROJ + C_K + h * 64 + lane; const bf16* pv_ = PROJ + C_V + h * 64 + rq * 16 + rl;
    const float* mu = F.in[I_MU];
    const float mur = mu[C_R + h * 64 + lane], muk = mu[C_K + h * 64 + lane], muv = mu[C_V + h * 64 + rq * 16 + rl], ka = F.in[I_K_A][h * 64 + lane];
    float s[16];
#pragma unroll
    for (int i = 0; i < 16; ++i) s[i] = 0.f;
    float prr = 0.f, prk = 0.f, prv = 0.f;
    constexpr int U = 8;
    unsigned short cr[U], ck[U], cv[U], ca[U], ckk[U]; float cw[U];
#pragma unroll
    for (int u = 0; u < U; ++u) { cr[u] = pr_[(size_t)u * IN0]; ck[u] = pk_[(size_t)u * IN0]; cv[u] = pv_[(size_t)u * IN0]; ca[u] = AA[(size_t)u * 512]; ckk[u] = KKp[(size_t)u * 512]; cw[u] = DEC[(size_t)u * 512]; }
    for (int t0 = 0; t0 < SEQ; t0 += U) {
        unsigned short nr[U], nk[U], nv[U], na[U], nkk[U]; float nw[U];
#pragma unroll
        for (int u = 0; u < U; ++u) { int tn = t0 + U + u; tn = tn < SEQ ? tn : SEQ - 1;
            nr[u] = pr_[(size_t)tn * IN0]; nk[u] = pk_[(size_t)tn * IN0]; nv[u] = pv_[(size_t)tn * IN0]; na[u] = AA[(size_t)tn * 512]; nkk[u] = KKp[(size_t)tn * 512]; nw[u] = DEC[(size_t)tn * 512]; }
#pragma unroll
        for (int u = 0; u < U; ++u) {
            const float r = bf2f(cr[u]), k = bf2f(ck[u]), v = bf2f(cv[u]), a = bf2f(ca[u]), kk = bf2f(ckk[u]), w = cw[u];
            const float rs = r + (prr - r) * mur, ks = k + (prk - k) * muk, vs = v + (prv - v) * muv; prr = r; prk = k; prv = v;
            const float kmod = ks * (1.0f + (a - 1.0f) * ka), kka = kk * a;
            float p0, p1; rwkv_dot16(p0, p1, s, kk);
            const float sa = -allreduce_rows(p0 + p1);
            rwkv_update0(s, w, kka, kmod, sa, vs); rwkv_update1(s, w, kka, kmod, sa, vs);
            rwkv_dot16(p0, p1, s, rs);
            const float y = allreduce_rows(p0 + p1);
            if (lane < 16) Y[(size_t)(t0 + u) * 1024] = (bf16)(pkbf(y, 0.f) & 0xffffu);
        }
#pragma unroll
        for (int u = 0; u < U; ++u) { cr[u] = nr[u]; ck[u] = nk[u]; cv[u] = nv[u]; ca[u] = na[u]; ckk[u] = nkk[u]; cw[u] = nw[u]; }
    }
}
__device__ __forceinline__ void lru_scan_wave(const Ctx& F, int task) {
    const int lane = F.lane, b = task >> 3, c = (task & 7) * 64 + lane;
    const float* A = (const float*)(F.ws + WS_LRUA) + (size_t)b * SEQ * 512 + c;
    const bf16* X = (const bf16*)((const unsigned char*)F.out + DO_LRUX) + (size_t)b * SEQ * 512 + c;
    const bf16* Gt = (const bf16*)(F.ws + WS_R1) + (size_t)b * SEQ * IN0 + C_LG + c;
    bf16* O = (bf16*)(F.ws + WS_XB) + (size_t)b * SEQ * 1024 + 512 + c;
    float hst = 0.f;
    constexpr int U = 8;
    for (int t0 = 0; t0 < SEQ; t0 += U) {
        float a[U]; unsigned short x[U], g[U];
#pragma unroll
        for (int u = 0; u < U; ++u) { a[u] = A[(size_t)(t0 + u) * 512]; x[u] = X[(size_t)(t0 + u) * 512]; g[u] = Gt[(size_t)(t0 + u) * IN0]; }
#pragma unroll
        for (int u = 0; u < U; ++u) { hst = a[u] * hst + bf2f(x[u]); const float o = hst * gelu_tanh(bf2f(g[u])); O[(size_t)(t0 + u) * 1024] = (bf16)(pkbf(o, 0.f) & 0xffffu); }
    }
}
__device__ __forceinline__ void p4_scans(const Ctx& F) {
    if (F.vcu < 128) { if (F.wave < 4) rwkv_scan_wave(F, F.vcu, F.wave); }
    else { if (F.wave == 0) lru_scan_wave(F, F.vcu - 128); }
}

__device__ __forceinline__ void unpack8(const v4u x, float (&o)[8]) { o[0] = bflo(x.x); o[1] = bfhi(x.x); o[2] = bflo(x.y); o[3] = bfhi(x.y); o[4] = bflo(x.z); o[5] = bfhi(x.z); o[6] = bflo(x.w); o[7] = bfhi(x.w); }
__device__ __forceinline__ float red8(float v) { v += __shfl_xor(v, 1); v += __shfl_xor(v, 2); v += __shfl_xor(v, 4); return v; }
__device__ __forceinline__ void p5_postscan(const Ctx& F) {
    const int gw = F.vcu * NWAVES + F.wave, NGW = F.G * NWAVES, lane = F.lane, c0 = 8 * lane;
    const bf16* PROJ = (const bf16*)(F.ws + WS_R1); bf16* MIX = (bf16*)(F.ws + WS_XB);
    const bf16* AA = (const bf16*)(F.ws + WS_AARR); const bf16* Gg = (const bf16*)((const unsigned char*)F.out + DO_G);
    float mur[8], muk[8], muv[8], ka[8], rk[8], lw[8], lb[8];
#pragma unroll
    for (int e = 0; e < 8; ++e) { mur[e] = F.in[I_MU][C_R + c0 + e]; muk[e] = F.in[I_MU][C_K + c0 + e]; muv[e] = F.in[I_MU][C_V + c0 + e]; ka[e] = F.in[I_K_A][c0 + e]; rk[e] = F.in[I_R_K][c0 + e];
        lw[e] = F.in[I_LNX_W][c0 + e]; lb[e] = F.in[I_LNX_B][c0 + e]; }
    const v4u z4 = (v4u){0u, 0u, 0u, 0u};
    for (int m = gw; m < MTOK; m += NGW) { const int t = m & (SEQ - 1); const bf16* p = PROJ + (size_t)m * IN0 + c0;
        const v4u yw = *(const v4u*)(MIX + (size_t)m * 1024 + c0), aw = *(const v4u*)(AA + (size_t)m * 512 + c0), gw_ = *(const v4u*)(Gg + (size_t)m * 512 + c0);
        const v4u rc = *(const v4u*)(p + C_R), kc = *(const v4u*)(p + C_K), vc = *(const v4u*)(p + C_V);
        v4u rp = z4, kp = z4, vp = z4; if (t > 0) { rp = *(const v4u*)(p - IN0 + C_R); kp = *(const v4u*)(p - IN0 + C_K); vp = *(const v4u*)(p - IN0 + C_V); }
        float y[8], a[8], g[8], r[8], k[8], v[8], r1[8], k1[8], v1[8];
        unpack8(yw, y); unpack8(aw, a); unpack8(gw_, g); unpack8(rc, r); unpack8(kc, k); unpack8(vc, v); unpack8(rp, r1); unpack8(kp, k1); unpack8(vp, v1);
        float sy = 0.f, bon = 0.f; float vs[8];
#pragma unroll
        for (int e = 0; e < 8; ++e) { const float rs = r[e] + (r1[e] - r[e]) * mur[e], ks = k[e] + (k1[e] - k[e]) * muk[e]; vs[e] = v[e] + (v1[e] - v[e]) * muv[e];
            const float kmod = ks * (1.0f + (a[e] - 1.0f) * ka[e]); bon += rs * kmod * rk[e]; sy += y[e]; }
        sy = red8(sy); bon = red8(bon);
        const float mean = sy * (1.0f / 64.0f); float sq = 0.f;
#pragma unroll
        for (int e = 0; e < 8; ++e) { const float d = y[e] - mean; sq += d * d; }
        sq = red8(sq);
        const float rstd = rsqrtf(sq * (1.0f / 64.0f) + GN_EPS); float o[8];
#pragma unroll
        for (int e = 0; e < 8; ++e) o[e] = ((y[e] - mean) * rstd * lw[e] + lb[e] + bon * vs[e]) * g[e];
        v4u w; w.x = pkbf(o[0], o[1]); w.y = pkbf(o[2], o[3]); w.z = pkbf(o[4], o[5]); w.w = pkbf(o[6], o[7]);
        *(v4u*)(MIX + (size_t)m * 1024 + c0) = w; }
}

__device__ __forceinline__ void p14_final(const Ctx& F) {
    const int gw = F.vcu * NWAVES + F.wave, NGW = F.G * NWAVES;
    f32x4 gn[4];
#pragma unroll
    for (int j = 0; j < 4; ++j) gn[j] = ((const f32x4*)F.in[I_NORM_FINAL])[F.lane + 64 * j];
    for (int m = gw; m < MTOK; m += NGW) { f32x4* xr = (f32x4*)(F.out + (size_t)m * DM) + F.lane; f32x4 v[4]; float s = 0.f;
#pragma unroll
        for (int j = 0; j < 4; ++j) { v[j] = xr[64 * j]; s += (v[j][0] * v[j][0] + v[j][1] * v[j][1]) + (v[j][2] * v[j][2] + v[j][3] * v[j][3]); }
        const float rs = rsqrtf(wave_sum(s) * (1.0f / 1024.0f) + NORM_EPS);
#pragma unroll
        for (int j = 0; j < 4; ++j) xr[64 * j] = v[j] * rs * gn[j]; }
}


__device__ __forceinline__ void dsa_phase(const Ctx& F) {
    const int lane = F.lane, wave = F.wave, kl = lane & 15, g = lane >> 4;
    LAS unsigned char* sc = F.lds + wave * 10240;
    const bf16* Q = (const bf16*)(F.ws + WS_Q); const bf16* KR = (const bf16*)(F.ws + WS_KR); const bf16* VT = (const bf16*)(F.ws + WS_VT);
    const bf16* IQ = (const bf16*)(F.ws + WS_IQ); const bf16* IK = (const bf16*)(F.ws + WS_IK); const float* IW = (const float*)(F.ws + WS_IW);
    bf16* ATT = (bf16*)(F.ws + WS_R1);
    const int b = F.vcu >> 4, sub = F.vcu & 15;
    const size_t rowb = (size_t)b * SEQ;
    for (int j = 0; j < 8; ++j) {
        const int grp = ((j & 1) ? (15 - sub) : sub) + 16 * j;
        const int adm = ((grp >> 2) + 1) * 64;
        const int q0 = grp * 16 + 2 * wave;
        { bf16x8 aq[2];
#pragma unroll
          for (int ks = 0; ks < 2; ++ks) aq[ks] = *(const bf16x8*)(IQ + (rowb + q0 + (kl >> 3)) * 512 + (kl & 7) * 64 + 8 * g + 32 * ks);
          const f32x4 iw4 = *(const f32x4*)(IW + (rowb + q0 + (g >> 1)) * 8 + 4 * (g & 1));
          const int nt16 = adm >> 4;
          for (int t = 0; t < nt16; ++t) { const bf16* ikp = IK + (rowb + 16 * t + kl) * 64 + 8 * g;
              const bf16x8 b0 = *(const bf16x8*)ikp, b1 = *(const bf16x8*)(ikp + 32);
              f32x4 c = (f32x4){0.f, 0.f, 0.f, 0.f};
              c = __builtin_amdgcn_mfma_f32_16x16x32_bf16(aq[0], b0, c, 0, 0, 0); c = __builtin_amdgcn_mfma_f32_16x16x32_bf16(aq[1], b1, c, 0, 0, 0);
              float part = (iw4[0] * fmaxf(c[0], 0.f) + iw4[1] * fmaxf(c[1], 0.f)) + (iw4[2] * fmaxf(c[2], 0.f) + iw4[3] * fmaxf(c[3], 0.f));
              float tot = part + __shfl_xor(part, 16);
              tot = fminf(fmaxf(tot, -60000.f), 60000.f);
              const _Float16 hv = (_Float16)tot; const unsigned short hb = __builtin_bit_cast(unsigned short, hv);
              const int key = 16 * t + kl;
              if ((g & 1) == 0) *(LAS unsigned short*)(sc + (g >> 1) * 5120 + (key >> 5) * 80 + (key & 31) * 2) = hb; } }
        unsigned maskw[2];
#pragma unroll
        for (int qi = 0; qi < 2; ++qi) {
            unsigned mk = 0u;
            if (adm <= 256) { mk = (lane < (adm >> 5)) ? 0xffffffffu : 0u; }
            else {
                const LAS unsigned char* sp = sc + qi * 5120 + lane * 80;
                const v4u w0 = *(const LAS v4u*)(sp), w1 = *(const LAS v4u*)(sp + 16), w2 = *(const LAS v4u*)(sp + 32), w3 = *(const LAS v4u*)(sp + 48);
                const unsigned ww[16] = {w0.x, w0.y, w0.z, w0.w, w1.x, w1.y, w1.z, w1.w, w2.x, w2.y, w2.z, w2.w, w3.x, w3.y, w3.z, w3.w};
                const bool live = lane < (adm >> 5);
                unsigned u[32];
#pragma unroll
                for (int i = 0; i < 32; ++i) { const unsigned raw = (ww[i >> 1] >> (16 * (i & 1))) & 0xffffu; const unsigned o = raw ^ ((raw & 0x8000u) ? 0xffffu : 0x8000u); u[i] = live ? o : 0u; }
                unsigned T = 0u;
                for (int bit = 15; bit >= 0; --bit) { const unsigned cand = T | (1u << bit); int cnt = 0;
#pragma unroll
                    for (int i = 0; i < 32; ++i) cnt += __popcll(__ballot(u[i] >= cand));
                    if (cnt >= 256) T = cand; }
                int ngt = 0, ceq = 0;
#pragma unroll
                for (int i = 0; i < 32; ++i) { ngt += __popcll(__ballot(u[i] > T)); ceq += (u[i] == T) ? 1 : 0; }
                const int need = 256 - ngt;
                int incl = ceq;
#pragma unroll
                for (int o = 1; o < 64; o <<= 1) { const int up = __shfl_up(incl, o); if (lane >= o) incl += up; }
                int run = incl - ceq;
#pragma unroll
                for (int i = 0; i < 32; ++i) { bool sel = u[i] > T; if (u[i] == T) { sel = run < need; ++run; } mk |= sel ? (1u << i) : 0u; }
            }
            maskw[qi] = mk;
        }
#pragma unroll
        for (int qi = 0; qi < 2; ++qi) {
            const size_t qrow = rowb + q0 + qi;
            bf16x8 bq[2];
#pragma unroll
            for (int ks = 0; ks < 2; ++ks) bq[ks] = *(const bf16x8*)(Q + qrow * 1024 + kl * 64 + 8 * g + 32 * ks);
            f32x4 o[4];
#pragma unroll
            for (int dt = 0; dt < 4; ++dt) o[dt] = (f32x4){0.f, 0.f, 0.f, 0.f};
            float mref = -1e30f, lpart = 0.f;
            const int nt32 = adm >> 5;
            for (int tt = 0; tt < nt32; ++tt) {
                const unsigned w = (unsigned)__builtin_amdgcn_readlane((int)maskw[qi], tt);
                if (w == 0u) continue;
                const bf16* kp = KR + (rowb + 32 * tt + kl) * 64 + 8 * g;
                const bf16x8 k00 = *(const bf16x8*)kp, k01 = *(const bf16x8*)(kp + 32), k10 = *(const bf16x8*)(kp + 1024), k11 = *(const bf16x8*)(kp + 1024 + 32);
                f32x4 c0 = (f32x4){0.f, 0.f, 0.f, 0.f}, c1 = c0;
                c0 = __builtin_amdgcn_mfma_f32_16x16x32_bf16(k00, bq[0], c0, 0, 0, 0); c0 = __builtin_amdgcn_mfma_f32_16x16x32_bf16(k01, bq[1], c0, 0, 0, 0);
                c1 = __builtin_amdgcn_mfma_f32_16x16x32_bf16(k10, bq[0], c1, 0, 0, 0); c1 = __builtin_amdgcn_mfma_f32_16x16x32_bf16(k11, bq[1], c1, 0, 0, 0);
                const unsigned bits = ((w >> (4 * g)) & 0xfu) | (((w >> (16 + 4 * g)) & 0xfu) << 4);
                float sv[8]; float tmax = -1e30f;
#pragma unroll
                for (int e = 0; e < 8; ++e) { const float x = e < 4 ? c0[e] : c1[e - 4]; sv[e] = ((bits >> e) & 1u) ? x : -1e30f; tmax = fmaxf(tmax, sv[e]); }
                if (__any(tmax > mref + 8.0f)) { float mn = fmaxf(mref, tmax); mn = fmaxf(mn, __shfl_xor(mn, 16)); mn = fmaxf(mn, __shfl_xor(mn, 32));
                    const float scl = __expf(mref - mn);
#pragma unroll
                    for (int dt = 0; dt < 4; ++dt) o[dt] = o[dt] * scl;
                    lpart *= scl; mref = mn; }
                float p[8];
#pragma unroll
                for (int e = 0; e < 8; ++e) { p[e] = ((bits >> e) & 1u) ? __expf(sv[e] - mref) : 0.f; lpart += p[e]; }
                v4u pw; pw.x = pkbf(p[0], p[1]); pw.y = pkbf(p[2], p[3]); pw.z = pkbf(p[4], p[5]); pw.w = pkbf(p[6], p[7]);
                const bf16x8 pb = __builtin_bit_cast(bf16x8, pw);
#pragma unroll
                for (int dt = 0; dt < 4; ++dt) { const bf16* vp = VT + ((size_t)b * 64 + 16 * dt + kl) * SEQ + 32 * tt + 4 * g;
                    const u32x2 v0 = *(const u32x2*)vp, v1 = *(const u32x2*)(vp + 16);
                    v4u vw; vw.x = v0.x; vw.y = v0.y; vw.z = v1.x; vw.w = v1.y;
                    o[dt] = __builtin_amdgcn_mfma_f32_16x16x32_bf16(__builtin_bit_cast(bf16x8, vw), pb, o[dt], 0, 0, 0); }
            }
            float l = lpart; l += __shfl_xor(l, 16); l += __shfl_xor(l, 32);
            const float inv = 1.0f / l;
#pragma unroll
            for (int dt = 0; dt < 4; ++dt) { u32x2 w2; w2.x = pkbf(o[dt][0] * inv, o[dt][1] * inv); w2.y = pkbf(o[dt][2] * inv, o[dt][3] * inv);
                *(u32x2*)(ATT + qrow * 1024 + kl * 64 + 16 * dt + 4 * g) = w2; }
        }
    }
}

#ifndef MK_SINGLE
#define MK_SINGLE 0
#endif
constexpr int N_PHASES = 15;
struct Args { const float* in[29]; float* out; unsigned char* ws; int ph_lo, ph_hi; };
static_assert(sizeof(Args) == 29 * 8 + 8 + 8 + 8, "Args has no padding");

template <class Epi>
__device__ __forceinline__ void run_gemm(const Ctx& F, const bf16* A, const bf16* Bt, int N, int K, const Epi& E) {
    int Kv = K; asm volatile("" : "+s"(Kv));
    pg8::Gemm g{A, Bt, MTOK, N, Kv}; pg8::StaticOrder S; S.init(MTOK, N, F.G, (int)blockIdx.x);
    pg8::gemm_phase<Epi, pg8::StaticOrder, true, true>(F.lds + RING_OFF, g, S, E);
}

__global__ void __launch_bounds__(NWAVES * 64, 2) mk_fwd(Args args) {
    extern __shared__ __attribute__((aligned(16))) unsigned char lds[];
    Ctx F;
    F.lds = (LAS unsigned char*)lds;
    F.tid = threadIdx.x; F.lane = F.tid & 63; F.wave = __builtin_amdgcn_readfirstlane(F.tid >> 6);
    F.G = gridDim.x; { const int bx = blockIdx.x; F.vcu = (F.G % 8 == 0) ? (bx % 8) * (F.G / 8) + bx / 8 : bx; }
    F.in = args.in;
    F.out = args.out; F.ws = args.ws;
    unsigned char* ws = args.ws;
    for (int u = F.tid; u < (LDS_BYTES - LDSCTL_OFF) / 4; u += NWAVES * 64) ((LAS unsigned*)(F.lds + LDSCTL_OFF))[u] = 0u;
    __syncthreads();
    const int lo = args.ph_lo, hi = args.ph_hi;
    const bool multi = (hi - lo) > 1;
    XcdBarrier bar; bar.bar = (unsigned*)(ws + WS_CTL) + CW_BAR; bar.x = 0; bar.st = nullptr;
    if (multi) bar = xcd_barrier_post((unsigned*)(ws + WS_CTL) + CW_BAR, (volatile LAS unsigned*)(F.lds + MISC_OFF) + 8);
#ifndef PHASE_MASK
#define PHASE_MASK 0x7fff
#endif
#define IN(k) (((PHASE_MASK >> (k)) & 1) && lo <= (k) && (k) < hi)
#define SEAM(k) do { if (IN(k) && IN((k) + 1)) xcd_barrier(bar); } while (0)
    float* ssq = (float*)(ws + WS_SSQ);
    bf16* XB = (bf16*)(ws + WS_XB);

    if (IN(0)) { p0_prologue(F); } SEAM(0);
    if (IN(1)) { EpiScaleBf16 E{(bf16*)(ws + WS_R1), IN0, ssq}; run_gemm(F, XB, (const bf16*)(ws + WS_W_IN0T), IN0, 1024, E); } SEAM(1);
    if (IN(2)) { p2a_prep(F); } SEAM(2);
    if (IN(3)) {
#ifndef P3_SEL
#define P3_SEL 3
#endif
        if (P3_SEL & 1) { const bf16* AL = (const bf16*)(ws + WS_ALORA); const bf16* BL = (const bf16*)(ws + WS_W_LORAT);
          { EpiLora<0> E{F.in[I_W_DECAY0], (float*)(ws + WS_DECAY), nullptr}; run_gemm(F, AL, BL, 512, 256, E); }
          { EpiLora<1> E{F.in[I_A_BIAS], nullptr, (bf16*)(ws + WS_AARR)}; run_gemm(F, AL, BL + 512 * 256, 512, 256, E); }
          { EpiLora<2> E{nullptr, nullptr, (bf16*)((unsigned char*)F.out + DO_G)}; run_gemm(F, AL, BL + 1024 * 256, 512, 256, E); } }
        if (P3_SEL & 2) { EpiGate E{F.in[I_B_RGATE], F.in[I_B_IGATE], F.in[I_LAMBDA], (const bf16*)((unsigned char*)F.out + DO_XC), (float*)(ws + WS_LRUA), (bf16*)((unsigned char*)F.out + DO_LRUX)};
          run_gemm(F, (const bf16*)((unsigned char*)F.out + DO_XC), (const bf16*)(ws + WS_W_GATET), 1024, 512, E); }
    } SEAM(3);
    if (IN(4)) { p4_scans(F); } SEAM(4);
    if (IN(5)) { p5_postscan(F); } SEAM(5);
    if (IN(6)) { EpiResid E{F.in[I_X], F.out, (bf16*)(ws + WS_R2), ssq}; run_gemm(F, XB, (const bf16*)(ws + WS_W_OUT0T), 1024, 1024, E); } SEAM(6);
    if (IN(7)) { EpiSwiglu E{(bf16*)(ws + WS_R1), ssq}; run_gemm(F, (const bf16*)(ws + WS_R2), (const bf16*)(ws + WS_W_GU0T), 2 * FFH, 1024, E); } SEAM(7);
    if (IN(8)) { EpiResid E{F.out, F.out, XB, ssq}; run_gemm(F, (const bf16*)(ws + WS_R1), (const bf16*)(ws + WS_W_DN0T), 1024, FFH, E); } SEAM(8);
    if (IN(9)) { EpiProj1 E{ssq, (const float*)(ws + WS_ROPE), (const float*)(ws + WS_ROPE) + SEQ * 32, (bf16*)(ws + WS_Q), (bf16*)(ws + WS_KR), (bf16*)(ws + WS_VT), (bf16*)(ws + WS_IQ), (bf16*)(ws + WS_IK), (float*)(ws + WS_IW)};
                 run_gemm(F, XB, (const bf16*)(ws + WS_W_IN1T), IN1P, 1024, E); } SEAM(9);
    if (IN(10)) { dsa_phase(F); } SEAM(10);
    if (IN(11)) { EpiResid E{F.out, F.out, XB, ssq}; run_gemm(F, (const bf16*)(ws + WS_R1), (const bf16*)(ws + WS_W_OUT1T), 1024, 1024, E); } SEAM(11);
    if (IN(12)) { EpiSwiglu E{(bf16*)(ws + WS_R2), ssq}; run_gemm(F, XB, (const bf16*)(ws + WS_W_GU1T), 2 * FFH, 1024, E); } SEAM(12);
    if (IN(13)) { EpiResid E{F.out, F.out, nullptr, ssq}; run_gemm(F, (const bf16*)(ws + WS_R2), (const bf16*)(ws + WS_W_DN1T), 1024, FFH, E); } SEAM(13);
    if (IN(14)) { p14_final(F); }
#undef IN
#undef SEAM
}

extern "C" void kernel_launch(void* const* d_in, const int* in_sizes, int n_in, void* d_out, int out_size, void* d_ws, size_t ws_size, hipStream_t stream) {
    static int grid = 0;
    if (grid == 0) {
        if (n_in != 29 || in_sizes[0] != MTOK * DM || out_size != MTOK * DM || ws_size < WS_END) {
            fprintf(stderr, "kernel_launch: unexpected shapes (n_in %d, in0 %d, out %d, ws %zu); nothing launched\n", n_in, n_in > 0 ? in_sizes[0] : -1, out_size, ws_size); grid = -1; return; }
        int dev = 0, cus = 0;
        if (hipGetDevice(&dev) != hipSuccess || hipDeviceGetAttribute(&cus, hipDeviceAttributeMultiprocessorCount, dev) != hipSuccess) { grid = -1; return; }
        if (hipFuncSetAttribute((const void*)mk_fwd, hipFuncAttributeMaxDynamicSharedMemorySize, LDS_BYTES) != hipSuccess) { fprintf(stderr, "kernel_launch: hipFuncSetAttribute failed\n"); grid = -1; return; }
        int per_cu = 0;
        if (hipOccupancyMaxActiveBlocksPerMultiprocessor(&per_cu, (const void*)mk_fwd, NWAVES * 64, LDS_BYTES) != hipSuccess || per_cu < 1)
            fprintf(stderr, "kernel_launch: note: occupancy query reports %d workgroups per CU\n", per_cu);
        (void)hipGetLastError();
        grid = cus;
        if (grid != 256) { fprintf(stderr, "kernel_launch: this kernel needs a 256-CU device (got %d)\n", grid); grid = -1; return; }
    }
    if (grid < 0) return;
    if (hipMemsetAsync((char*)d_ws + WS_CTL, 0, CTL_ZERO_BYTES, stream) != hipSuccess) { fprintf(stderr, "kernel_launch: memset failed\n"); return; }
    Args a{};
    for (int i = 0; i < 29; ++i) a.in[i] = (const float*)d_in[i];
    a.out = (float*)d_out; a.ws = (unsigned char*)d_ws;
#if MK_SINGLE
    a.ph_lo = 0; a.ph_hi = N_PHASES;
    hipLaunchKernelGGL(mk_fwd, dim3(grid), dim3(NWAVES * 64), LDS_BYTES, stream, a);
#else
    for (int p = 0; p < N_PHASES; ++p) { a.ph_lo = p; a.ph_hi = p + 1; hipLaunchKernelGGL(mk_fwd, dim3(grid), dim3(NWAVES * 64), LDS_BYTES, stream, a); }
#endif
}
```

```cpp
#include <hip/hip_runtime.h>
#include <cstdio>
#include <cstdint>
namespace pg8 {
#define PG8_LAS __attribute__((address_space(3)))
typedef unsigned short bf16_t;
typedef short bf16x8 __attribute__((ext_vector_type(8)));
typedef float f32x4 __attribute__((ext_vector_type(4)));
typedef unsigned u32x4 __attribute__((ext_vector_type(4)));
constexpr int BM = 256, BK = 64, HALF = 128, HTB = HALF * BK * 2  , STAGE_BYTES = 8 * HTB, NXCD = 8;

__host__ __device__ __forceinline__ int lds_byte(int r, int c) { const int st = (r >> 4) * 2 + (c >> 5), rr = r & 15, cc = c & 31, ob = rr * 64 + cc * 2; return st * 1024 + (ob ^ (((ob >> 9) & 1) << 5)); }
__host__ __device__ __forceinline__ void stage_rc(int b, int& R, int& C) { const int st = b / 1024, sb = b % 1024, swz = sb ^ (((sb >> 9) & 1) << 5); R = (st >> 1) * 16 + swz / 64; C = (st & 1) * 32 + (swz % 64) / 2; }
__host__ __device__ __forceinline__ int perm32(int rho) { const int n = rho >> 4, i = rho & 15; return 8 * (i >> 2) + 4 * n + (i & 3); }

struct Unit { int pm, pn; };
struct Gemm { const bf16_t* A; const bf16_t* Bt; int M, N, K; };

struct StaticOrder {
    int nM, nN, nwg, G, c, WGM;
    __host__ __device__ void init(int M, int N, int G_, int c_, int wgm) { nM = M / BM; nN = N / BM; nwg = nM * nN; G = G_; c = c_; WGM = wgm; }
    __host__ __device__ bool next(int i, Unit& u) const {
        const long L = (long)i * G + c; if (L >= nwg) return false;
        int wgid = (int)L; { const int q = nwg / NXCD, r = nwg % NXCD, xcd = wgid % NXCD, off = wgid / NXCD; wgid = (xcd < r ? xcd * (q + 1) : r * (q + 1) + (xcd - r) * q) + off; }
        const int nig = WGM * nN, gid = wgid / nig, fm = gid * WGM, gsz = (nM - fm) < WGM ? (nM - fm) : WGM;
        u.pm = fm + ((wgid % nig) % gsz); u.pn = (wgid % nig) / gsz; return true;
    }
    __device__ __forceinline__ void a_ready(const Unit&) const {}
    __device__ __forceinline__ void done(const Unit&) const {}
};
typedef __bf16 bf16x2_t __attribute__((ext_vector_type(2)));
typedef float f32x2_t __attribute__((ext_vector_type(2)));
__device__ __forceinline__ unsigned cvt_pk_bf16(float lo, float hi) { const f32x2_t v = {lo, hi}; return __builtin_bit_cast(unsigned, __builtin_convertvector(v, bf16x2_t)); }
template <class Epi, class Sched, bool ALIGN_EPI = false, bool SP2 = false>
__device__ __forceinline__ void gemm_phase(PG8_LAS unsigned char* lds, const Gemm g, const Sched& S, const Epi& E) {
    const int tid = threadIdx.x, wid = __builtin_amdgcn_readfirstlane(tid >> 6), lane = tid & 63, wr = wid >> 2, wc = wid & 3, fr = lane & 15, fq = lane >> 4;
    const int K = g.K, nt = K / BK;
    unsigned voffA[2], voffB[2];
#pragma unroll
    for (int i = 0; i < 2; ++i) { int R, C; stage_rc(tid * 16 + i * 8192, R, C); const int Rb = Epi::PERM ? ((R & ~31) + perm32(R & 31)) : R;
        voffA[i] = (unsigned)(R * K + C) * 2u; voffB[i] = (unsigned)(Rb * K + C) * 2u; }
    const size_t kstep = (size_t)(BK * 2);
    const size_t hstep = (size_t)HALF * K * 2;
    const size_t tstep = 2 * hstep;
    const unsigned ldsw = (unsigned)wid * 1024u;
    const int aoff = lds_byte(wr * 64 + fr, fq * 8), boff = lds_byte(wc * 32 + fr, fq * 8);
#define PG8_SA(b, h) (((b) * 2 + (h)) * HTB)
#define PG8_SB(b, h) ((4 + (b) * 2 + (h)) * HTB)
#define PG8_STAGE_(bufoff, gbase, voff, AUX) do { _Pragma("unroll") for (int _i = 0; _i < 2; ++_i) \
        __builtin_amdgcn_global_load_lds((const unsigned*)((const char*)(gbase) + (voff)[_i]), (PG8_LAS unsigned*)(lds + (bufoff) + ldsw + _i * 8192), 16, 0, AUX); } while (0)
#ifndef PG8_B_AUX
#define PG8_B_AUX 2
#endif
#define PG8_STAGE(bufoff, gbase, voff) PG8_STAGE_(bufoff, gbase, voff, 0)
#define PG8_STAGE_B(bufoff, gbase, voff) PG8_STAGE_(bufoff, gbase, voff, PG8_B_AUX)
#define PG8_LDA(dst, b, h) do { _Pragma("unroll") for (int m = 0; m < 4; ++m) _Pragma("unroll") for (int k = 0; k < 2; ++k) dst[m][k] = *(const PG8_LAS bf16x8*)(lds + PG8_SA(b, h) + aoff + m * 2048 + k * 1024); } while (0)
#define PG8_LDB(dst, b, h) do { _Pragma("unroll") for (int n = 0; n < 2; ++n) _Pragma("unroll") for (int k = 0; k < 2; ++k) dst[n][k] = *(const PG8_LAS bf16x8*)(lds + PG8_SB(b, h) + boff + n * 2048 + k * 1024); } while (0)
#define PG8_MMA(ai, bj, At, Bt) do { __builtin_amdgcn_s_setprio(1); _Pragma("unroll") for (int m = 0; m < 4; ++m) _Pragma("unroll") for (int n = 0; n < 2; ++n) _Pragma("unroll") for (int k = 0; k < 2; ++k) \
        acc[ai][bj][m][n] = __builtin_amdgcn_mfma_f32_16x16x32_bf16(Bt[n][k], At[m][k], acc[ai][bj][m][n], 0, 0, 0); __builtin_amdgcn_s_setprio(0); } while (0)
#define PG8_WAIT_V(n) asm volatile("s_waitcnt vmcnt(" #n ")" ::: "memory")
#define PG8_WAIT_L(n) asm volatile("s_waitcnt lgkmcnt(" #n ")" ::: "memory")
#define PG8_BAR __builtin_amdgcn_s_barrier()
#define PG8_SCHED __builtin_amdgcn_sched_barrier(0)
    Unit cur, nxt; int ui = 0;
    if (!S.next(0, cur)) return;
    f32x4 acc[2][2][4][2];
#pragma unroll
    for (int a = 0; a < 2; ++a)
#pragma unroll
        for (int b = 0; b < 2; ++b)
#pragma unroll
            for (int m = 0; m < 4; ++m)
#pragma unroll
                for (int n = 0; n < 2; ++n) acc[a][b][m][n] = (f32x4){0.f, 0.f, 0.f, 0.f};
    bf16x8 At[4][2], B0[2][2], B1[2][2];
    const char* cA = (const char*)g.A + (size_t)cur.pm * tstep; const char* cB = (const char*)g.Bt + (size_t)cur.pn * tstep;
    S.a_ready(cur);
    if constexpr (SP2) {
        PG8_STAGE_B(PG8_SB(0, 0), cB, voffB); PG8_STAGE_B(PG8_SB(0, 1), cB + hstep, voffB); PG8_STAGE(PG8_SA(0, 0), cA, voffA); PG8_STAGE(PG8_SA(0, 1), cA + hstep, voffA);
        if (wr == 1) PG8_BAR;
        PG8_WAIT_V(2); PG8_BAR;
        PG8_STAGE_B(PG8_SB(1, 0), cB + kstep, voffB); PG8_STAGE(PG8_SA(1, 0), cA + kstep, voffA); PG8_STAGE_B(PG8_SB(1, 1), cB + hstep + kstep, voffB);
        PG8_WAIT_V(6); PG8_BAR;
    } else {
        PG8_STAGE_B(PG8_SB(0, 0), cB, voffB); PG8_STAGE(PG8_SA(0, 0), cA, voffA); PG8_STAGE_B(PG8_SB(0, 1), cB + hstep, voffB); PG8_STAGE(PG8_SA(0, 1), cA + hstep, voffA);
        if (wr == 1) PG8_BAR;
        PG8_WAIT_V(4); PG8_BAR;
        PG8_STAGE_B(PG8_SB(1, 0), cB + kstep, voffB); PG8_STAGE(PG8_SA(1, 0), cA + kstep, voffA); PG8_STAGE_B(PG8_SB(1, 1), cB + hstep + kstep, voffB);
        PG8_WAIT_V(6); PG8_BAR;
    }
    for (;;) {
        const bool has_next = S.next(ui + 1, nxt);
        const char* nA = has_next ? (const char*)g.A + (size_t)nxt.pm * tstep : cA; const char* nB = has_next ? (const char*)g.Bt + (size_t)nxt.pn * tstep : cB;
        for (int t = 0; t < nt; t += 2) {
            const bool last = (t == nt - 2);
            const char* a1 = cA + (size_t)(t + 1) * kstep;
            const char* a2 = last ? nA : cA + (size_t)(t + 2) * kstep; const char* b2 = last ? nB : cB + (size_t)(t + 2) * kstep;
            const char* a3 = a2 + kstep; const char* b3 = b2 + kstep;
            if (last && has_next) S.a_ready(nxt);
            if constexpr (SP2) {
            PG8_LDB(B0, 0, 0); PG8_LDB(B1, 0, 1); PG8_SCHED; PG8_LDA(At, 0, 0); PG8_STAGE(PG8_SA(1, 1), a1 + hstep, voffA);
            PG8_WAIT_V(8); PG8_WAIT_L(0); PG8_BAR; PG8_MMA(0, 0, At, B0); PG8_MMA(0, 1, At, B1); PG8_BAR; PG8_SCHED;
            PG8_LDA(At, 0, 1); PG8_STAGE_B(PG8_SB(0, 0), b2, voffB); PG8_STAGE_B(PG8_SB(0, 1), b2 + hstep, voffB); PG8_STAGE(PG8_SA(0, 0), a2, voffA);
            PG8_WAIT_V(8); PG8_WAIT_L(0); PG8_BAR; PG8_MMA(1, 0, At, B0); PG8_MMA(1, 1, At, B1); PG8_BAR; PG8_SCHED;
            PG8_LDB(B0, 1, 0); PG8_LDB(B1, 1, 1); PG8_SCHED; PG8_LDA(At, 1, 0); PG8_STAGE(PG8_SA(0, 1), a2 + hstep, voffA);
            PG8_WAIT_V(8); PG8_WAIT_L(0); PG8_BAR; PG8_MMA(0, 0, At, B0); PG8_MMA(0, 1, At, B1); PG8_BAR; PG8_SCHED;
            PG8_LDA(At, 1, 1); PG8_STAGE_B(PG8_SB(1, 0), b3, voffB); PG8_STAGE_B(PG8_SB(1, 1), b3 + hstep, voffB); PG8_STAGE(PG8_SA(1, 0), a3, voffA);
            PG8_WAIT_V(8); PG8_WAIT_L(0); PG8_BAR; PG8_MMA(1, 0, At, B0); PG8_MMA(1, 1, At, B1); PG8_BAR; PG8_SCHED;
            } else {
            PG8_LDB(B0, 0, 0); PG8_SCHED; PG8_LDA(At, 0, 0); PG8_STAGE(PG8_SA(1, 1), a1 + hstep, voffA);
            PG8_WAIT_L(8); PG8_BAR; PG8_WAIT_L(0); PG8_MMA(0, 0, At, B0); PG8_BAR; PG8_SCHED;
            PG8_LDB(B1, 0, 1); PG8_STAGE_B(PG8_SB(0, 0), b2, voffB);
            PG8_BAR; PG8_WAIT_L(0); PG8_MMA(0, 1, At, B1); PG8_BAR;
            PG8_LDA(At, 0, 1); PG8_STAGE(PG8_SA(0, 0), a2, voffA);
            PG8_BAR; PG8_WAIT_L(0); PG8_MMA(1, 0, At, B0); PG8_BAR; PG8_SCHED;
            PG8_STAGE_B(PG8_SB(0, 1), b2 + hstep, voffB);
            PG8_WAIT_V(6); PG8_BAR; PG8_MMA(1, 1, At, B1); PG8_BAR;
            PG8_LDB(B0, 1, 0); PG8_SCHED; PG8_LDA(At, 1, 0); PG8_STAGE(PG8_SA(0, 1), a2 + hstep, voffA);
            PG8_WAIT_L(8); PG8_BAR; PG8_WAIT_L(0); PG8_MMA(0, 0, At, B0); PG8_BAR; PG8_SCHED;
            PG8_LDB(B1, 1, 1); PG8_STAGE_B(PG8_SB(1, 0), b3, voffB);
            PG8_BAR; PG8_WAIT_L(0); PG8_MMA(0, 1, At, B1); PG8_BAR;
            PG8_LDA(At, 1, 1); PG8_STAGE(PG8_SA(1, 0), a3, voffA);
            PG8_BAR; PG8_WAIT_L(0); PG8_MMA(1, 0, At, B0); PG8_BAR; PG8_SCHED;
            PG8_STAGE_B(PG8_SB(1, 1), b3 + hstep, voffB);
            PG8_WAIT_V(6); PG8_BAR; PG8_MMA(1, 1, At, B1); PG8_BAR;
            }
        }
        typename Epi::Pre pre_; { int pfr = fr, pfq = fq; asm volatile("" : "+v"(pfr), "+v"(pfq)); E.pre(pre_, cur, wr, pfr, pfq); }
        if constexpr (ALIGN_EPI) { if (wr == 0) PG8_BAR; }
        if constexpr (!Epi::AFTER_DRAIN) { int efr = fr, efq = fq; asm volatile("" : "+v"(efr), "+v"(efq));
            E(acc, cur, wr, wc, efr, efq, pre_); S.done(cur); }
        if (!has_next) break;
#pragma unroll
        for (int a = 0; a < 2; ++a)
#pragma unroll
            for (int b = 0; b < 2; ++b)
#pragma unroll
                for (int m = 0; m < 4; ++m)
#pragma unroll
                    for (int n = 0; n < 2; ++n) acc[a][b][m][n] = (f32x4){0.f, 0.f, 0.f, 0.f};
        cur = nxt; cA = nA; cB = nB; ++ui;
        if constexpr (ALIGN_EPI) { if (wr == 1) PG8_BAR; }
    }
    PG8_WAIT_V(0);
    if constexpr (!ALIGN_EPI) { if (wr == 0) PG8_BAR; }
    PG8_BAR;
    if constexpr (Epi::AFTER_DRAIN) { E.fused(acc, cur, wr, wc, fr, fq, lds, wid, lane); S.done(cur); }
#undef PG8_SA
#undef PG8_SB
#undef PG8_STAGE
#undef PG8_STAGE_
#undef PG8_STAGE_B
#undef PG8_LDA
#undef PG8_LDB
#undef PG8_MMA
#undef PG8_WAIT_V
#undef PG8_WAIT_L
#undef PG8_BAR
#undef PG8_SCHED
}
}
#define GAS __attribute__((address_space(1)))
#define LAS __attribute__((address_space(3)))
typedef unsigned short bf16;
typedef unsigned v4u __attribute__((ext_vector_type(4)));
typedef float f32x4 __attribute__((ext_vector_type(4)));
typedef short bf16x8 __attribute__((ext_vector_type(8)));
typedef GAS unsigned gu32;
typedef GAS unsigned long long gu64;
#define RLX_AGENT __ATOMIC_RELAXED, __HIP_MEMORY_SCOPE_AGENT
#define LDS_WAIT() asm volatile("s_waitcnt lgkmcnt(0)" ::: "memory")
#define VM_WAIT() asm volatile("s_waitcnt vmcnt(0)" ::: "memory")
__device__ __forceinline__ unsigned long long rt() { return __builtin_amdgcn_s_memrealtime(); }
__device__ __forceinline__ unsigned f2bf(float f) { unsigned u = __builtin_bit_cast(unsigned, f); return (u + 0x7fffu + ((u >> 16) & 1u)) >> 16; }
__device__ __forceinline__ unsigned pk2(float lo, float hi) { return f2bf(lo) | (f2bf(hi) << 16); }

#define XB_TMO      128
#define XB_XCNT(j)  (256  + 64 * (j))
#define XB_XSUB(j)  (1280 + 64 * (j))
#define XB_XGEN(j)  (2304 + 64 * (j))
#define XB_TOP      3328
#define XB_TOPGEN   3392
#define XCD_BAR_WORDS 3456
#define XB_SPIN_CAP (1u << 18)

__device__ __forceinline__ unsigned xb_ld(unsigned* p)              { return __hip_atomic_load(p, __ATOMIC_RELAXED, __HIP_MEMORY_SCOPE_AGENT); }
__device__ __forceinline__ unsigned xb_add(unsigned* p, unsigned v) { return __hip_atomic_fetch_add(p, v, __ATOMIC_RELAXED, __HIP_MEMORY_SCOPE_AGENT); }
__device__ __forceinline__ unsigned xb_xcc_id() { return (unsigned)__builtin_amdgcn_s_getreg((3 << 11) | 20) & 0xFu; }
#define XB_SPIN(cond, bar) do { unsigned _sp = 0; while (cond) { __builtin_amdgcn_s_sleep(1); \
    if ((++_sp & 255u) == 0u) { if (xb_ld(&(bar)[XB_TMO])) break; if (_sp > XB_SPIN_CAP) { atomicAdd(&(bar)[XB_TMO], 1u); break; } } } } while (0)

struct XcdBarrier {
    unsigned* bar; unsigned x;
    volatile LAS unsigned* st;
};

__device__ __forceinline__ XcdBarrier xcd_barrier_post(unsigned* bar, volatile LAS unsigned* st) {
    XcdBarrier b; b.bar = bar; b.x = xb_xcc_id(); b.st = st;
    if (threadIdx.x == 0) (void)xb_add(&bar[XB_XCNT(b.x)], 1u);
    return b;
}
__device__ __forceinline__ void xcd_barrier_complete(unsigned* bar, unsigned x, unsigned& nloc, unsigned& nx) {
    const unsigned G = gridDim.x * gridDim.y * gridDim.z;
    unsigned sum, cnt, mine, sp = 0u;
    for (;;) {
        sum = 0u; cnt = 0u; mine = 0u;
#pragma unroll
        for (unsigned j = 0; j < 16; ++j) { const unsigned c = xb_ld(&bar[XB_XCNT(j)]); sum += c; cnt += (c > 0u) ? 1u : 0u; mine = (j == x) ? c : mine; }
        if (sum == G) break;
        __builtin_amdgcn_s_sleep(1);
        if ((++sp & 255u) == 0u) { if (xb_ld(&bar[XB_TMO])) break; if (sp > XB_SPIN_CAP) { atomicAdd(&bar[XB_TMO], 1u); break; } }
    }
    nloc = mine > 0u ? mine : 1u; nx = cnt > 0u ? cnt : 1u;
}

__device__ __forceinline__ void xcd_barrier(const XcdBarrier& b) {
    asm volatile("s_waitcnt vmcnt(0)" ::: "memory");
    __syncthreads();
    if (threadIdx.x == 0) {
        unsigned* bar = b.bar;
        __builtin_amdgcn_s_waitcnt(0);
        unsigned nloc = b.st[0], nx = b.st[1];
        if (nloc == 0u) { xcd_barrier_complete(bar, b.x, nloc, nx); b.st[0] = nloc; b.st[1] = nx; }
        const unsigned old = xb_add(&bar[XB_XSUB(b.x)], 1u);
        const unsigned gen = old / nloc;
        if (old + 1u == (gen + 1u) * nloc) {
            __builtin_amdgcn_fence(__ATOMIC_RELEASE, "agent");
            asm volatile("s_waitcnt vmcnt(0)" ::: "memory");
            const unsigned og = xb_add(&bar[XB_TOP], 1u);
            const unsigned tg = og / nx;
            if (og + 1u == (tg + 1u) * nx) xb_add(&bar[XB_TOPGEN], 1u);
            else XB_SPIN(xb_ld(&bar[XB_TOPGEN]) == tg, bar);
            __builtin_amdgcn_fence(__ATOMIC_ACQUIRE, "agent");
            xb_add(&bar[XB_XGEN(b.x)], 1u);
            asm volatile("s_waitcnt vmcnt(0)" ::: "memory");
        } else {
            XB_SPIN(xb_ld(&bar[XB_XGEN(b.x)]) == gen, bar);
            __builtin_amdgcn_fence(__ATOMIC_ACQUIRE, "agent");
            asm volatile("s_waitcnt vmcnt(0)" ::: "memory");
        }
    }
    __syncthreads();
}

constexpr int NWAVES = 8;
constexpr int BATCH = 16, SEQ = 2048, DM = 1024, MTOK = BATCH * SEQ;
constexpr int IN0 = 2816, FFH = 2816, IN1 = 1736, IN1P = 1792, RWKVW = 512, LRUW = 512;
constexpr float NORM_EPS = 1e-6f, GN_EPS = 64e-5f;
constexpr int C_R = 0, C_K = 512, C_V = 1024, C_WD = 1536, C_LX = 1792, C_LG = 2304;

constexpr size_t MiB = 1u << 20;
constexpr size_t WS_CTL = 0, CTL_ZERO_BYTES = 64 * 1024;
constexpr size_t WS_W_IN0T = 1 * MiB, WS_W_OUT0T = 7 * MiB, WS_W_GU0T = 9 * MiB, WS_W_DN0T = 20 * MiB, WS_W_IN1T = 26 * MiB, WS_W_OUT1T = 30 * MiB,
                 WS_W_GU1T = 32 * MiB, WS_W_DN1T = 43 * MiB, WS_W_LORAT = 49 * MiB, WS_W_GATET = 50 * MiB, WS_ROPE = 51 * MiB, WS_SSQ = 52 * MiB;
constexpr size_t WS_XB = 64 * MiB, WS_R1 = 128 * MiB, WS_R2 = 304 * MiB, WS_END = 480 * MiB;
constexpr size_t WS_DECAY = WS_R2, WS_LRUA = WS_R2 + 64 * MiB, WS_AARR = WS_R2 + 128 * MiB, WS_ALORA = WS_R2 + 160 * MiB;
constexpr size_t DO_G = 0, DO_LRUA1 = 64 * MiB, DO_LRUX = 96 * MiB;
constexpr size_t WS_Q = WS_R2, WS_IQ = WS_R2 + 64 * MiB, WS_KR = WS_R2 + 96 * MiB, WS_VT = WS_R2 + 100 * MiB, WS_IK = WS_R2 + 104 * MiB, WS_IW = WS_R2 + 108 * MiB;
constexpr size_t WS_BONUS = 58 * MiB;
constexpr size_t WS_LRUPS = 500 * MiB, WS_HIN = 508 * MiB;
constexpr int CW_BAR = 1024;

constexpr int RING_OFF = 0, RING_BYTES = 131072;
constexpr int LDSCTL_OFF = RING_BYTES, MISC_OFF = LDSCTL_OFF + 320;
constexpr int LDS_BYTES = 163840;
constexpr int EPI_LDS_OFF = 132096, EPI_LDS_WAVE = 3968;

typedef unsigned u32x2 __attribute__((ext_vector_type(2)));
typedef unsigned short u16x4 __attribute__((ext_vector_type(4)));
typedef unsigned short u16x8 __attribute__((ext_vector_type(8)));
typedef float f32x2 __attribute__((ext_vector_type(2)));

__device__ __forceinline__ float bf2f(unsigned b) { return __builtin_bit_cast(float, b << 16); }
__device__ __forceinline__ float bflo(unsigned w) { return __builtin_bit_cast(float, w << 16); }
__device__ __forceinline__ float bfhi(unsigned w) { return __builtin_bit_cast(float, w & 0xffff0000u); }
__device__ __forceinline__ unsigned pkbf(float lo, float hi) { return pg8::cvt_pk_bf16(lo, hi); }
__device__ __forceinline__ float sigmoidf_(float x) { return __builtin_amdgcn_rcpf(1.0f + __expf(-x)); }
__device__ __forceinline__ float softplusf_(float u) { return fmaxf(u, 0.f) + __logf(1.0f + __expf(-fabsf(u))); }
__device__ __forceinline__ float one_minus_exp(float x) { return x > -0.02f ? -x * (1.0f + x * (0.5f + x * (0.16666667f + x * 0.041666668f))) : 1.0f - __expf(x); }
__device__ __forceinline__ float tanhf_(float x) { const float e = __expf(-2.0f * fabsf(x)); const float t = (1.0f - e) * __builtin_amdgcn_rcpf(1.0f + e); return x < 0.f ? -t : t; }
__device__ __forceinline__ float gelu_tanh(float x) { const float u = 0.7978845608028654f * (x + 0.044715f * x * x * x); return 0.5f * x * (1.0f + tanhf_(u)); }
__device__ __forceinline__ float row_rstd(const float* ssq, int row) {
    const f32x4* p = (const f32x4*)(ssq + (size_t)row * 16);
    const f32x4 a = p[0], b = p[1], c = p[2], d = p[3];
    const float s = (((a[0] + a[1]) + (a[2] + a[3])) + ((b[0] + b[1]) + (b[2] + b[3]))) + (((c[0] + c[1]) + (c[2] + c[3])) + ((d[0] + d[1]) + (d[2] + d[3])));
    return rsqrtf(s * (1.0f / 1024.0f) + NORM_EPS);
}


template <int CTRL> __device__ __forceinline__ float dpp_mov(float x) { return __builtin_bit_cast(float, __builtin_amdgcn_update_dpp(0, __builtin_bit_cast(int, x), CTRL, 0xf, 0xf, true)); }
#define DPP_QP_1032 0xB1
#define DPP_QP_2301 0x4E
#define DPP_ROW_HALF_MIRROR 0x141
#define DPP_ROW_MIRROR 0x140
__device__ __forceinline__ float row8_sum(float x) {
    x += dpp_mov<DPP_QP_1032>(x); x += dpp_mov<DPP_QP_2301>(x); x += dpp_mov<DPP_ROW_HALF_MIRROR>(x); return x; }
template <int CTRL, int RM> __device__ __forceinline__ int dpp_src0(int x) { return __builtin_amdgcn_update_dpp(0, x, CTRL, RM, 0xf, false); }
__device__ __forceinline__ int wave_prefix_incl(int x) {
    x += dpp_src0<0x111, 0xf>(x); x += dpp_src0<0x112, 0xf>(x); x += dpp_src0<0x114, 0xf>(x); x += dpp_src0<0x118, 0xf>(x);
    x += dpp_src0<0x142, 0xa>(x); x += dpp_src0<0x143, 0xc>(x); return x; }
__device__ __forceinline__ float row16_sum(float x) {
    x = row8_sum(x); x += dpp_mov<DPP_ROW_MIRROR>(x); return x; }
__device__ __forceinline__ void rows_gather4(float x, float& r0, float& r1, float& r2, float& r3) {
    const unsigned xi = __builtin_bit_cast(unsigned, x);
    const auto s = __builtin_amdgcn_permlane16_swap(xi, xi, false, false);
    const auto t0 = __builtin_amdgcn_permlane32_swap((unsigned)s[0], (unsigned)s[0], false, false), t1 = __builtin_amdgcn_permlane32_swap((unsigned)s[1], (unsigned)s[1], false, false);
    r0 = __builtin_bit_cast(float, (unsigned)t0[0]); r2 = __builtin_bit_cast(float, (unsigned)t0[1]); r1 = __builtin_bit_cast(float, (unsigned)t1[0]); r3 = __builtin_bit_cast(float, (unsigned)t1[1]);
}

using pg8::Unit;
__device__ __forceinline__ v4u epi_to_rows(LAS unsigned char* s, const v4u v, int fr, int fq) { const int l = fq * 16 + fr;
    *(LAS v4u*)(s + fr * 80 + fq * 16) = v; return *(const LAS v4u*)(s + (l >> 2) * 80 + (l & 3) * 16); }
__device__ __forceinline__ v4u epi_from_rows(LAS unsigned char* s, const v4u v, int fr, int fq) { const int l = fq * 16 + fr;
    *(LAS v4u*)(s + (l >> 2) * 80 + (l & 3) * 16) = v; return *(const LAS v4u*)(s + fr * 80 + fq * 16); }
struct EpiPre { f32x4 p[2][4]; };
__device__ __forceinline__ void epi_rstd_load(const float* ssq, int rb0, int fr, int fq, EpiPre& P) { const int l = fq * 16 + fr;
#pragma unroll
    for (int ai = 0; ai < 2; ++ai)
#pragma unroll
        for (int m = 0; m < 4; ++m) P.p[ai][m] = *(const f32x4*)(ssq + (size_t)(rb0 + ai * 128 + m * 16 + (l >> 2)) * 16 + 4 * (l & 3));
}
__device__ __forceinline__ void epi_rstd_finish(const EpiPre& P, int fr, float (&rs)[2][4]) {
#pragma unroll
    for (int ai = 0; ai < 2; ++ai)
#pragma unroll
        for (int m = 0; m < 4; ++m) { const f32x4 p = P.p[ai][m];
            float s = (p[0] + p[1]) + (p[2] + p[3]); s += dpp_mov<DPP_QP_1032>(s); s += dpp_mov<DPP_QP_2301>(s);
            rs[ai][m] = __shfl(rsqrtf(s * (1.0f / 1024.0f) + NORM_EPS), 4 * fr); }
}
__device__ __forceinline__ void epi_rstd(const float* ssq, int rb0, int fr, int fq, float (&rs)[2][4]) { EpiPre P; epi_rstd_load(ssq, rb0, fr, fq, P); epi_rstd_finish(P, fr, rs); }
struct EpiScaleBf16 {
    typedef EpiPre Pre;
    static constexpr bool PERM = true, AFTER_DRAIN = false;
    bf16* O; int ldc; const float* ssq; LAS unsigned char* eb;
    __device__ __forceinline__ void pre(EpiPre& P, const Unit& u, int wr, int fr, int fq) const { epi_rstd_load(ssq, u.pm * 256 + wr * 64, fr, fq, P); }
    __device__ __forceinline__ void operator()(const f32x4 (&acc)[2][2][4][2], const Unit& u, int wr, int wc, int fr, int fq, const EpiPre& P) const {
        const int l = fq * 16 + fr, rb0 = u.pm * 256 + wr * 64, cw = u.pn * 256 + wc * 32;
        float rs[2][4]; epi_rstd_finish(P, fr, rs);
#pragma unroll
        for (int ai = 0; ai < 2; ++ai)
#pragma unroll
            for (int m = 0; m < 4; ++m) { const float r = rs[ai][m]; bf16* rowp = O + (size_t)(rb0 + ai * 128 + m * 16 + (l >> 2)) * ldc + cw + 8 * (l & 3);
#pragma unroll
                for (int bj = 0; bj < 2; ++bj) { const f32x4 v0 = acc[ai][bj][m][0] * r, v1 = acc[ai][bj][m][1] * r;
                    v4u w; w.x = pkbf(v0[0], v0[1]); w.y = pkbf(v0[2], v0[3]); w.z = pkbf(v1[0], v1[1]); w.w = pkbf(v1[2], v1[3]);
                    *(v4u*)(rowp + bj * 128) = epi_to_rows(eb + ((m * 2 + bj) % 3) * 1280, w, fr, fq); } }
    }
};
struct EpiSwiglu {
    typedef EpiPre Pre;
    static constexpr bool PERM = true, AFTER_DRAIN = false;
    bf16* O; const float* ssq; LAS unsigned char* eb;
    __device__ __forceinline__ void pre(EpiPre& P, const Unit& u, int wr, int fr, int fq) const { epi_rstd_load(ssq, u.pm * 256 + wr * 64, fr, fq, P); }
    __device__ __forceinline__ void operator()(const f32x4 (&acc)[2][2][4][2], const Unit& u, int wr, int wc, int fr, int fq, const EpiPre& P) const {
        const int l = fq * 16 + fr, rb0 = u.pm * 256 + wr * 64, cw = u.pn * 128 + wc * 32;
        float rs[2][4]; epi_rstd_finish(P, fr, rs);
#pragma unroll
        for (int ai = 0; ai < 2; ++ai)
#pragma unroll
            for (int m = 0; m < 4; ++m) { const float r = rs[ai][m];
                float a[8];
#pragma unroll
                for (int n = 0; n < 2; ++n)
#pragma unroll
                    for (int e = 0; e < 4; ++e) { const float g = acc[ai][0][m][n][e] * r, up = acc[ai][1][m][n][e] * r; a[n * 4 + e] = g * __builtin_amdgcn_rcpf(1.0f + __expf(-g)) * up; }
                v4u w; w.x = pkbf(a[0], a[1]); w.y = pkbf(a[2], a[3]); w.z = pkbf(a[4], a[5]); w.w = pkbf(a[6], a[7]);
                *(v4u*)(O + (size_t)(rb0 + ai * 128 + m * 16 + (l >> 2)) * FFH + cw + 8 * (l & 3)) = epi_to_rows(eb + (m % 3) * 1280, w, fr, fq); }
    }
};
template <bool RESID_BF16> struct EpiResid {
    typedef EpiPre Pre;
    static constexpr bool PERM = true, AFTER_DRAIN = false;
    const void* resid; bf16* xb; float* ssq; LAS unsigned char* eb;
    __device__ __forceinline__ void pre(EpiPre&, const Unit&, int, int, int) const {}
    __device__ __forceinline__ void operator()(const f32x4 (&acc)[2][2][4][2], const Unit& u, int wr, int wc, int fr, int fq, const EpiPre&) const {
        const int l = fq * 16 + fr, rb0 = u.pm * 256 + wr * 64, cw = u.pn * 256 + wc * 32;
        if constexpr (RESID_BF16) {
            v4u rv[2][4][2];
#pragma unroll
            for (int ai = 0; ai < 2; ++ai)
#pragma unroll
                for (int m = 0; m < 4; ++m)
#pragma unroll
                    for (int bj = 0; bj < 2; ++bj) rv[ai][m][bj] = *(const v4u*)((const bf16*)resid + (size_t)(rb0 + ai * 128 + m * 16 + (l >> 2)) * DM + cw + bj * 128 + 8 * (l & 3));
#pragma unroll
            for (int ai = 0; ai < 2; ++ai)
#pragma unroll
                for (int m = 0; m < 4; ++m) { const int rbase = rb0 + ai * 128 + m * 16; float ss = 0.f;
#pragma unroll
                    for (int bj = 0; bj < 2; ++bj) { const v4u rf = epi_from_rows(eb + bj * 1280, rv[ai][m][bj], fr, fq);
                        const f32x4 o0 = (f32x4){bflo(rf.x), bfhi(rf.x), bflo(rf.y), bfhi(rf.y)} + acc[ai][bj][m][0], o1 = (f32x4){bflo(rf.z), bfhi(rf.z), bflo(rf.w), bfhi(rf.w)} + acc[ai][bj][m][1];
                        ss += ((o0[0] * o0[0] + o0[1] * o0[1]) + (o0[2] * o0[2] + o0[3] * o0[3])) + ((o1[0] * o1[0] + o1[1] * o1[1]) + (o1[2] * o1[2] + o1[3] * o1[3]));
                        v4u w; w.x = pkbf(o0[0], o0[1]); w.y = pkbf(o0[2], o0[3]); w.z = pkbf(o1[0], o1[1]); w.w = pkbf(o1[2], o1[3]);
                        *(v4u*)(xb + (size_t)(rbase + (l >> 2)) * DM + cw + bj * 128 + 8 * (l & 3)) = epi_to_rows(eb + 2560, w, fr, fq); }
                    ss += __shfl_xor(ss, 16); ss += __shfl_xor(ss, 32);
                    if (fq == 0) ssq[(size_t)(rbase + fr) * 16 + u.pn * 4 + wc] = ss; }
        } else {
#pragma unroll
            for (int ai = 0; ai < 2; ++ai) {
                f32x4 rv[4][2][2];
#pragma unroll
                for (int m = 0; m < 4; ++m)
#pragma unroll
                    for (int bj = 0; bj < 2; ++bj)
#pragma unroll
                        for (int i = 0; i < 2; ++i) rv[m][bj][i] = *(const f32x4*)((const float*)resid + (size_t)(rb0 + ai * 128 + m * 16 + (l >> 3) + 8 * i) * DM + cw + bj * 128 + 4 * (l & 7));
#pragma unroll
                for (int m = 0; m < 4; ++m) { const int rbase = rb0 + ai * 128 + m * 16; float ss = 0.f;
#pragma unroll
                    for (int bj = 0; bj < 2; ++bj) {
#pragma unroll
                        for (int i = 0; i < 2; ++i) *(LAS f32x4*)(eb + ((l >> 3) + 8 * i) * 144 + (l & 7) * 16) = rv[m][bj][i];
                        const f32x4 o0 = *(const LAS f32x4*)(eb + fr * 144 + fq * 32) + acc[ai][bj][m][0], o1 = *(const LAS f32x4*)(eb + fr * 144 + fq * 32 + 16) + acc[ai][bj][m][1];
                        ss += ((o0[0] * o0[0] + o0[1] * o0[1]) + (o0[2] * o0[2] + o0[3] * o0[3])) + ((o1[0] * o1[0] + o1[1] * o1[1]) + (o1[2] * o1[2] + o1[3] * o1[3]));
                        v4u w; w.x = pkbf(o0[0], o0[1]); w.y = pkbf(o0[2], o0[3]); w.z = pkbf(o1[0], o1[1]); w.w = pkbf(o1[2], o1[3]);
                        *(v4u*)(xb + (size_t)(rbase + (l >> 2)) * DM + cw + bj * 128 + 8 * (l & 3)) = epi_to_rows(eb + 2560, w, fr, fq); }
                    ss += __shfl_xor(ss, 16); ss += __shfl_xor(ss, 32);
                    if (fq == 0) ssq[(size_t)(rbase + fr) * 16 + u.pn * 4 + wc] = ss; } }
        }
    }
};
constexpr size_t WS_XCHG = 56 * MiB;
constexpr int CW_PANEL = 8192;
struct EpiResidFinal {
    typedef EpiPre Pre;
    static constexpr bool PERM = true, AFTER_DRAIN = false;
    const bf16* resid; float* out; const float* gain; float* xchg; unsigned* cnt; LAS unsigned char* eb;
    __device__ __forceinline__ void pre(EpiPre&, const Unit&, int, int, int) const {}
    __device__ __forceinline__ void operator()(const f32x4 (&acc_)[2][2][4][2], const Unit& u, int wr, int wc, int fr, int fq, const EpiPre&) const {
        f32x4 (&acc)[2][2][4][2] = const_cast<f32x4 (&)[2][2][4][2]>(acc_);
        const int l = fq * 16 + fr, rb0 = u.pm * 256 + wr * 64, cw = u.pn * 256 + wc * 32;
        { v4u rv[2][4][2];
#pragma unroll
          for (int ai = 0; ai < 2; ++ai)
#pragma unroll
              for (int m = 0; m < 4; ++m)
#pragma unroll
                  for (int bj = 0; bj < 2; ++bj) rv[ai][m][bj] = *(const v4u*)(resid + (size_t)(rb0 + ai * 128 + m * 16 + (l >> 2)) * DM + cw + bj * 128 + 8 * (l & 3));
#pragma unroll
          for (int ai = 0; ai < 2; ++ai)
#pragma unroll
              for (int m = 0; m < 4; ++m) { const int row = rb0 + ai * 128 + m * 16 + fr; float ss = 0.f;
#pragma unroll
                  for (int bj = 0; bj < 2; ++bj) { const v4u rf = epi_from_rows(eb + ((m * 2 + bj) % 3) * 1280, rv[ai][m][bj], fr, fq);
                      const f32x4 o0 = (f32x4){bflo(rf.x), bfhi(rf.x), bflo(rf.y), bfhi(rf.y)} + acc[ai][bj][m][0], o1 = (f32x4){bflo(rf.z), bfhi(rf.z), bflo(rf.w), bfhi(rf.w)} + acc[ai][bj][m][1];
                      acc[ai][bj][m][0] = o0; acc[ai][bj][m][1] = o1;
                      ss += ((o0[0] * o0[0] + o0[1] * o0[1]) + (o0[2] * o0[2] + o0[3] * o0[3])) + ((o1[0] * o1[0] + o1[1] * o1[1]) + (o1[2] * o1[2] + o1[3] * o1[3])); }
                  ss += __shfl_xor(ss, 16); ss += __shfl_xor(ss, 32);
                  if (fq == 0) __hip_atomic_store(xchg + (size_t)row * 16 + u.pn * 4 + wc, ss, __ATOMIC_RELAXED, __HIP_MEMORY_SCOPE_AGENT);
                  asm volatile("" ::: "memory"); } }
        asm volatile("s_waitcnt vmcnt(0)" ::: "memory");
        unsigned* c = cnt + 64 * u.pm;
        if ((threadIdx.x & 63) == 0) __hip_atomic_fetch_add(c, 1u, __ATOMIC_RELAXED, __HIP_MEMORY_SCOPE_AGENT);
        { unsigned spins = 0;
          while ((unsigned)__builtin_amdgcn_readfirstlane(__hip_atomic_load(c, __ATOMIC_RELAXED, __HIP_MEMORY_SCOPE_AGENT)) < 32u) { __builtin_amdgcn_s_sleep(2); if (++spins > (1u << 22)) break; } }
        __builtin_amdgcn_fence(__ATOMIC_ACQUIRE, "agent");
        asm volatile("s_waitcnt vmcnt(0)" ::: "memory");
        float rs[2][4]; epi_rstd(xchg, rb0, fr, fq, rs);
        const f32x4 g0 = *(const f32x4*)(gain + cw + 4 * (l & 7)), g1 = *(const f32x4*)(gain + cw + 128 + 4 * (l & 7));
#pragma unroll
        for (int ai = 0; ai < 2; ++ai)
#pragma unroll
            for (int m = 0; m < 4; ++m) { const int rbase = rb0 + ai * 128 + m * 16; const float r = rs[ai][m];
#pragma unroll
                for (int bj = 0; bj < 2; ++bj) {
                    *(LAS f32x4*)(eb + fr * 144 + fq * 32) = acc[ai][bj][m][0] * r; *(LAS f32x4*)(eb + fr * 144 + fq * 32 + 16) = acc[ai][bj][m][1] * r;
#pragma unroll
                    for (int i = 0; i < 2; ++i) { const f32x4 v = *(const LAS f32x4*)(eb + ((l >> 3) + 8 * i) * 144 + (l & 7) * 16);
                        *(f32x4*)(out + (size_t)(rbase + (l >> 3) + 8 * i) * DM + cw + bj * 128 + 4 * (l & 7)) = v * (bj ? g1 : g0); } }
                asm volatile("" ::: "memory"); }
    }
};
struct EpiProj1 {
    typedef EpiPre Pre;
    static constexpr bool PERM = false, AFTER_DRAIN = false;
    const float* ssq; const float* ropec; const float* ropes; bf16 *Q, *KR, *VT, *IQ, *IK; float* IW; LAS unsigned char* eb;
    template <int BJ> __device__ __forceinline__ void half(const f32x4 (&acc)[2][2][4][2], const Unit& u, int wr, int wc, int fr, int fq, const float (&rs)[2][4]) const {
        const int l = fq * 16 + fr, rb0 = u.pm * 256 + wr * 64;
        const int pc = u.pn * 256 + BJ * 128 + wc * 32, gi = pc >> 6, w = (pc >> 5) & 1;
        const bool rope = (gi <= 16) || (gi >= 18 && gi <= 26);
        const unsigned rvo = (unsigned)((l >> 2) * 128 + (l & 3) * 16);
        if (rope) {
#pragma unroll
            for (int am = 0; am < 4; ++am) { const int ai = am >> 1;
                v4u csr[4], snr[4];
#pragma unroll
                for (int m = 2 * (am & 1); m < 2 * (am & 1) + 2; ++m) { const int tb = (rb0 + ai * 128 + m * 16) & (SEQ - 1);
                    csr[m] = *(const v4u*)((const char*)(ropec + ((tb >> 4) * 2 + w) * 256) + l * 16); snr[m] = *(const v4u*)((const char*)(ropes + ((tb >> 4) * 2 + w) * 256) + l * 16); }
#pragma unroll
                for (int m = 2 * (am & 1); m < 2 * (am & 1) + 2; ++m) { const int rbase = rb0 + ai * 128 + m * 16; const float r = rs[ai][m];
                    const f32x4 x0 = acc[ai][BJ][m][0] * r, x1 = acc[ai][BJ][m][1] * r;
                    const f32x4 cs = __builtin_bit_cast(f32x4, csr[m]), sn = __builtin_bit_cast(f32x4, snr[m]);
                    f32x4 o1 = x0 * cs - x1 * sn, o2 = x0 * sn + x1 * cs;
                    if (gi <= 16) {
                        if (gi < 16) { o1 = o1 * 0.18033688011112042f; o2 = o2 * 0.18033688011112042f; }
                        u32x2 w1, w2; w1.x = pkbf(o1[0], o1[1]); w1.y = pkbf(o1[2], o1[3]); w2.x = pkbf(o2[0], o2[1]); w2.y = pkbf(o2[2], o2[3]);
                        *(LAS u32x2*)(eb + 2560 + fr * 80 + fq * 8) = w1; *(LAS u32x2*)(eb + 2560 + fr * 80 + 32 + fq * 8) = w2;
                        const v4u rd = *(const LAS v4u*)(eb + 2560 + (l >> 2) * 80 + ((l >> 1) & 1) * 32 + (l & 1) * 16);
                        const int dd = ((l >> 1) & 1) * 32 + (l & 1) * 8;
                        if (gi < 16) *(v4u*)((char*)(Q + (size_t)rbase * 1024 + gi * 64 + 16 * w) + (unsigned)(((l >> 2) * 1024 + dd) * 2)) = rd;
                        else *(v4u*)((char*)(KR + (size_t)rbase * 64 + 16 * w) + (unsigned)(((l >> 2) * 64 + dd) * 2)) = rd;
                    } else {
                        if (gi < 26) { o1 = o1 * 0.125f; o2 = o2 * 0.125f; }
                        const unsigned a0 = pkbf(o1[0], o1[1]), a1 = pkbf(o1[2], o1[3]), b0 = pkbf(o2[0], o2[1]), b1 = pkbf(o2[2], o2[3]);
                        const auto s0 = __builtin_amdgcn_permlane16_swap(a0, b0, false, false), s1 = __builtin_amdgcn_permlane16_swap(a1, b1, false, false);
                        v4u st; st.x = (unsigned)s0[0]; st.y = (unsigned)s1[0]; st.z = (unsigned)s0[1]; st.w = (unsigned)s1[1];
                        const int gsl = (fq >> 1) * 16;
                        if (gi < 26) *(v4u*)((char*)(IQ + (size_t)(rbase >> 1) * 1024 + (2 * w * 16 + (gi - 18)) * 8) + (unsigned)(((fr >> 1) * 1024 + (fq & 1) * 512 + (gsl + (fr & 1) * 8) * 8) * 2)) = st;
                        else *(v4u*)((char*)(IK + (size_t)(rbase >> 4) * 1024 + 2 * w * 16 * 8) + (unsigned)(((fq & 1) * 512 + (gsl + fr) * 8) * 2)) = st; } } }
        } else if (gi == 17) {
#pragma unroll
            for (int ai = 0; ai < 2; ++ai)
#pragma unroll
                for (int m = 0; m < 4; ++m) { const int rbase = rb0 + ai * 128 + m * 16; const float r = rs[ai][m];
                    const f32x4 x0 = acc[ai][BJ][m][0] * r, x1 = acc[ai][BJ][m][1] * r;
                    u32x2 w1, w2; w1.x = pkbf(x0[0], x0[1]); w1.y = pkbf(x0[2], x0[3]); w2.x = pkbf(x1[0], x1[1]); w2.y = pkbf(x1[2], x1[3]);
                    LAS unsigned char* sl = eb + (m % 3) * 1280;
                    *(LAS u32x2*)(sl + fr * 80 + fq * 8) = w1; *(LAS u32x2*)(sl + fr * 80 + 32 + fq * 8) = w2;
                    *(v4u*)((char*)(VT + (size_t)rbase * 64 + 32 * w) + rvo) = *(const LAS v4u*)(sl + (l >> 2) * 80 + (l & 3) * 16); }
        } else if (gi == 27) {
#pragma unroll
            for (int ai = 0; ai < 2; ++ai)
#pragma unroll
                for (int m = 0; m < 4; ++m) { const int row = rb0 + ai * 128 + m * 16 + fr; if (w == 0 && fq < 2) *(f32x4*)(IW + (size_t)row * 8 + 4 * fq) = acc[ai][BJ][m][0] * (rs[ai][m] * 0.35355339059327373f); }
        }
    }
    __device__ __forceinline__ void pre(EpiPre& P, const Unit& u, int wr, int fr, int fq) const { epi_rstd_load(ssq, u.pm * 256 + wr * 64, fr, fq, P); }
    __device__ __forceinline__ void operator()(const f32x4 (&acc)[2][2][4][2], const Unit& u, int wr, int wc, int fr, int fq, const EpiPre& P) const {
        float rs[2][4]; epi_rstd_finish(P, fr, rs);
        half<0>(acc, u, wr, wc, fr, fq, rs); half<1>(acc, u, wr, wc, fr, fq, rs);
    }
};


struct Ctx {
    LAS unsigned char* lds;
    int tid, lane, wave, vcu, G;
    const float* const* in; float* out; unsigned char* ws;
};
enum { I_X = 0, I_NORM_MIX, I_W_IN0, I_MU, I_W_DECAY0, I_W_DECAY_UP, I_A_BIAS, I_W_A_UP, I_W_G_UP, I_K_K, I_K_A, I_R_K, I_LNX_W, I_LNX_B, I_CONV_W, I_CONV_B,
       I_W_RGATE, I_B_RGATE, I_W_IGATE, I_B_IGATE, I_LAMBDA, I_W_OUT0, I_W_IN1, I_W_OUT1, I_NORM_FFN, I_FFN_GATE, I_FFN_UP, I_FFN_DOWN, I_NORM_FINAL };

__device__ __forceinline__ float wave_sum(float v) {
#pragma unroll
    for (int o = 1; o < 64; o <<= 1) v += __shfl_xor(v, o);
    return v;
}

enum { MAP_ID = 0, MAP_GATE = 1, MAP_UP = 2, MAP_IN1 = 3 };
__device__ __forceinline__ int map_row(int mode, int n) {
    if (mode == MAP_GATE) return (n >> 7) * 256 + (n & 127);
    if (mode == MAP_UP) return (n >> 7) * 256 + 128 + (n & 127);
    if (mode == MAP_IN1) { const int gi = n >> 6, d = n & 63; const bool rope = (gi <= 16) || (gi >= 18 && gi <= 26);
        if (!rope) return n;
        const int ph = d < 32 ? ((d >> 4) * 32 + (d & 15)) : (((d - 32) >> 4) * 32 + 16 + ((d - 32) & 15));
        return gi * 64 + ph; }
    return n;
}
__device__ __forceinline__ void p0_transpose_item(const float* W, int K, int N, int Npad, const float* gain, bf16* WT, int mode, LAS float* scr, int item, int lane) {
    const int nblk = Npad >> 6, kb = item / nblk, nb = item - kb * nblk, k0 = 64 * kb, n0 = 64 * nb;
    const int nq = 4 * (lane & 7);
    f32x4 v[2][8];
#pragma unroll
    for (int h = 0; h < 2; ++h) { const int ncol = n0 + 32 * h + nq; const bool cin = ncol < N;
#pragma unroll
        for (int i = 0; i < 8; ++i) { const int kk = 8 * i + (lane >> 3); v[h][i] = (f32x4){0.f, 0.f, 0.f, 0.f};
            if (cin) v[h][i] = *(const f32x4*)(W + (size_t)(k0 + kk) * N + ncol); } }
#pragma unroll
    for (int h = 0; h < 2; ++h) {
#pragma unroll
        for (int i = 0; i < 8; ++i) { const int kk = 8 * i + (lane >> 3); f32x4 x = v[h][i];
            if (gain) x = x * gain[k0 + kk];
            scr[kk * 33 + nq] = x[0]; scr[kk * 33 + nq + 1] = x[1]; scr[kk * 33 + nq + 2] = x[2]; scr[kk * 33 + nq + 3] = x[3]; }
        LDS_WAIT(); asm volatile("" ::: "memory");
        const int c = lane & 7;
#pragma unroll
        for (int j = 0; j < 4; ++j) { const int n = (lane >> 3) + 8 * j; const LAS float* s = scr + (8 * c) * 33 + n;
            v4u o; o.x = pkbf(s[0 * 33], s[1 * 33]); o.y = pkbf(s[2 * 33], s[3 * 33]); o.z = pkbf(s[4 * 33], s[5 * 33]); o.w = pkbf(s[6 * 33], s[7 * 33]);
            *(v4u*)(WT + (size_t)map_row(mode, n0 + 32 * h + n) * K + k0 + 8 * c) = o; }
        LDS_WAIT(); asm volatile("" ::: "memory"); }
}
__device__ __forceinline__ void p0_prologue(const Ctx& F) {
    LAS float* scr = (LAS float*)(F.lds + RING_OFF + F.wave * 16384);
    const int gw = F.vcu * NWAVES + F.wave, NGW = F.G * NWAVES;
    unsigned char* ws = F.ws;
    constexpr int I_A = 16 * 44, I_B = 16 * 16, I_D = 44 * 16, I_C = 16 * 28;
    constexpr int NITEMS = 7 * I_A + 2 * I_B + I_C;
    static_assert(I_A == I_D, "item counts");
    for (int it = gw; it < NITEMS; it += NGW) {
        int r = it;
        if (r < I_A) { p0_transpose_item(F.in[I_W_IN0], 1024, IN0, IN0, F.in[I_NORM_MIX], (bf16*)(ws + WS_W_IN0T), MAP_ID, scr, r, F.lane); continue; } r -= I_A;
        if (r < I_B) { p0_transpose_item(F.in[I_W_OUT0], 1024, 1024, 1024, nullptr, (bf16*)(ws + WS_W_OUT0T), MAP_ID, scr, r, F.lane); continue; } r -= I_B;
        if (r < I_A) { p0_transpose_item(F.in[I_FFN_GATE], 1024, FFH, FFH, F.in[I_NORM_FFN], (bf16*)(ws + WS_W_GU0T), MAP_GATE, scr, r, F.lane); continue; } r -= I_A;
        if (r < I_A) { p0_transpose_item(F.in[I_FFN_UP], 1024, FFH, FFH, F.in[I_NORM_FFN], (bf16*)(ws + WS_W_GU0T), MAP_UP, scr, r, F.lane); continue; } r -= I_A;
        if (r < I_D) { p0_transpose_item(F.in[I_FFN_DOWN], FFH, 1024, 1024, nullptr, (bf16*)(ws + WS_W_DN0T), MAP_ID, scr, r, F.lane); continue; } r -= I_D;
        if (r < I_C) { p0_transpose_item(F.in[I_W_IN1], 1024, IN1, IN1P, F.in[I_NORM_MIX] + 1024, (bf16*)(ws + WS_W_IN1T), MAP_IN1, scr, r, F.lane); continue; } r -= I_C;
        if (r < I_B) { p0_transpose_item(F.in[I_W_OUT1], 1024, 1024, 1024, nullptr, (bf16*)(ws + WS_W_OUT1T), MAP_ID, scr, r, F.lane); continue; } r -= I_B;
        if (r < I_A) { p0_transpose_item(F.in[I_FFN_GATE] + (size_t)1024 * FFH, 1024, FFH, FFH, F.in[I_NORM_FFN] + 1024, (bf16*)(ws + WS_W_GU1T), MAP_GATE, scr, r, F.lane); continue; } r -= I_A;
        if (r < I_A) { p0_transpose_item(F.in[I_FFN_UP] + (size_t)1024 * FFH, 1024, FFH, FFH, F.in[I_NORM_FFN] + 1024, (bf16*)(ws + WS_W_GU1T), MAP_UP, scr, r, F.lane); continue; } r -= I_A;
        p0_transpose_item(F.in[I_FFN_DOWN] + (size_t)FFH * 1024, FFH, 1024, 1024, nullptr, (bf16*)(ws + WS_W_DN1T), MAP_ID, scr, r, F.lane);
    }
    const int gt = F.vcu * (NWAVES * 64) + F.tid, NGT = F.G * NWAVES * 64;
    { bf16* L = (bf16*)(ws + WS_W_LORAT);
      for (int i = gt; i < 2 * 65536; i += NGT) { const int e = i & 7, ln = (i >> 3) & 63, gg = ln >> 4, cc = ln & 15; float v;
          if (i < 65536) { const int ks = (i >> 9) & 1, j = (i >> 10) & 3, h = (i >> 12) & 7, part = i >> 15; const int ch = 64 * h + 4 * cc + j, k = 32 * ks + 8 * gg + e;
              v = (part ? F.in[I_W_A_UP] : F.in[I_W_DECAY_UP])[k * 512 + ch]; }
          else { const int i2 = i - 65536, ks = (i2 >> 9) & 3, ct = (i2 >> 11) & 3, grp = i2 >> 13; const int n = 64 * grp + 16 * ct + cc, k = 32 * ks + 8 * gg + e;
              v = F.in[I_W_G_UP][k * 512 + n]; }
          L[i] = (bf16)(pkbf(v, 0.f) & 0xffffu); } }
    { bf16* Gt = (bf16*)(ws + WS_W_GATET);
      for (int i = gt; i < 65536; i += NGT) { const int e = i & 7, ln = (i >> 3) & 63, gg = ln >> 4, cc = ln & 15, ks = (i >> 9) & 1, ct = (i >> 10) & 3, gate = (i >> 12) & 1, h = i >> 13;
          const int jj = 16 * ct + cc, kk = 16 * (2 * ks + (e >> 2)) + 4 * gg + (e & 3);
          const float v = (gate ? F.in[I_W_IGATE] : F.in[I_W_RGATE])[h * 4096 + kk * 64 + jj];
          Gt[i] = (bf16)(pkbf(v, 0.f) & 0xffffu); } }
    { float* rc = (float*)(ws + WS_ROPE); float* rsn = rc + SEQ * 32;
      for (int i = gt; i < SEQ * 32; i += NGT) { const int t = i >> 5, f = i & 31; const float invf = (float)pow(10000.0, -(double)f / 32.0); const float ang = (float)t * invf;
          const int o = (((t >> 4) * 2 + (f >> 4)) * 64 + ((f >> 2) & 3) * 16 + (t & 15)) * 4 + (f & 3);
          rc[o] = (float)cos((double)ang); rsn[o] = (float)sin((double)ang); } }
    { float* lsp = (float*)(ws + WS_ROPE + 512 * 1024); for (int i = gt; i < 512; i += NGT) lsp[i] = -8.0f * softplusf_(-F.in[I_LAMBDA][i]); }
    { bf16* XB = (bf16*)(ws + WS_XB); float* ssq = (float*)(ws + WS_SSQ); const float* x = F.in[I_X];
      for (int m = gw; m < MTOK; m += NGW) { const f32x4* xr = (const f32x4*)(x + (size_t)m * DM) + F.lane; f32x4 v[4]; float s = 0.f;
#pragma unroll
          for (int j = 0; j < 4; ++j) { v[j] = xr[64 * j]; s += (v[j][0] * v[j][0] + v[j][1] * v[j][1]) + (v[j][2] * v[j][2] + v[j][3] * v[j][3]); }
          s = wave_sum(s);
          u32x2* o8 = (u32x2*)(XB + (size_t)m * DM) + F.lane;
#pragma unroll
          for (int j = 0; j < 4; ++j) { u32x2 w; w.x = pkbf(v[j][0], v[j][1]); w.y = pkbf(v[j][2], v[j][3]); o8[64 * j] = w; }
          if (F.lane < 16) ssq[(size_t)m * 16 + F.lane] = (F.lane == 0) ? s : 0.f; } }
}


__device__ __forceinline__ void unpack8(const v4u x, float (&o)[8]) { o[0] = bflo(x.x); o[1] = bfhi(x.x); o[2] = bflo(x.y); o[3] = bfhi(x.y); o[4] = bflo(x.z); o[5] = bfhi(x.z); o[6] = bflo(x.w); o[7] = bfhi(x.w); }
__device__ __forceinline__ float red8(float v) { return row8_sum(v); }
__device__ __forceinline__ void p5_postscan(const Ctx& F) {
    const int gw = F.vcu * NWAVES + F.wave, NGW = F.G * NWAVES, lane = F.lane, c0 = 8 * lane;
    const bf16* PROJ = (const bf16*)(F.ws + WS_R1); bf16* MIX = (bf16*)(F.ws + WS_XB);
    const bf16* Gg = (const bf16*)((const unsigned char*)F.out + DO_G); const float* BONUS = (const float*)(F.ws + WS_BONUS);
    float muv[8], lw[8], lb[8];
#pragma unroll
    for (int e = 0; e < 8; ++e) { muv[e] = F.in[I_MU][C_V + c0 + e]; lw[e] = F.in[I_LNX_W][c0 + e]; lb[e] = F.in[I_LNX_B][c0 + e]; }
    const v4u z4 = (v4u){0u, 0u, 0u, 0u};
    static_assert(MTOK == 256 * NWAVES * 16, "16 tokens per wave");
    const bf16* LRUC = (const bf16*)((const unsigned char*)F.out + DO_LRUA1); const bf16* LRUS = (const bf16*)((const unsigned char*)F.out + DO_LRUX);
    float hin[8];
    { const float* hp = (const float*)(F.ws + WS_HIN) + (size_t)gw * 512 + c0; const f32x4 h0 = *(const f32x4*)hp, h1 = *(const f32x4*)(hp + 4);
      hin[0] = h0[0]; hin[1] = h0[1]; hin[2] = h0[2]; hin[3] = h0[3]; hin[4] = h1[0]; hin[5] = h1[1]; hin[6] = h1[2]; hin[7] = h1[3]; }
    v4u vlast = z4;
    { const int m = gw * 16; if ((m & (SEQ - 1)) > 0) vlast = *(const v4u*)(PROJ + (size_t)(m - 1) * IN0 + c0 + C_V); }
#pragma nounroll
    for (int mb = gw * 16; mb < gw * 16 + 16; mb += 2) {
        v4u yw[2], gw_[2], vc[2], vp[2], hw[2], cw_[2], gt[2]; float bon[2];
#pragma unroll
        for (int u = 0; u < 2; ++u) { const int m = mb + u; const bf16* p = PROJ + (size_t)m * IN0 + c0;
            yw[u] = *(const v4u*)(MIX + (size_t)m * 1024 + c0); gw_[u] = *(const v4u*)(Gg + (size_t)m * 512 + c0); vc[u] = *(const v4u*)(p + C_V);
            hw[u] = *(const v4u*)(LRUS + (size_t)m * 512 + c0); cw_[u] = *(const v4u*)(LRUC + (size_t)m * 512 + c0); gt[u] = *(const v4u*)(p + C_LG);
            bon[u] = BONUS[(size_t)m * 8 + (lane >> 3)]; }
        vp[0] = vlast; vp[1] = vc[0]; vlast = vc[1];
#pragma unroll
        for (int u = 0; u < 2; ++u) { const int m = mb + u;
            float y[8], g[8], v[8], v1[8];
            unpack8(yw[u], y); unpack8(gw_[u], g); unpack8(vc[u], v); unpack8(vp[u], v1);
            float sy = 0.f; float vs[8];
#pragma unroll
            for (int e = 0; e < 8; ++e) { vs[e] = v[e] + (v1[e] - v[e]) * muv[e]; sy += y[e]; }
            sy = red8(sy);
            const float mean = sy * (1.0f / 64.0f); float sq = 0.f;
#pragma unroll
            for (int e = 0; e < 8; ++e) { const float d = y[e] - mean; sq += d * d; }
            sq = red8(sq);
            const float rstd = rsqrtf(sq * (1.0f / 64.0f) + GN_EPS); float o[8];
#pragma unroll
            for (int e = 0; e < 8; ++e) o[e] = ((y[e] - mean) * rstd * lw[e] + lb[e] + bon[u] * vs[e]) * g[e];
            v4u w; w.x = pkbf(o[0], o[1]); w.y = pkbf(o[2], o[3]); w.z = pkbf(o[4], o[5]); w.w = pkbf(o[6], o[7]);
            *(v4u*)(MIX + (size_t)m * 1024 + c0) = w;
            { float hh[8], cc8[8], gg[8], oo[8]; unpack8(hw[u], hh); unpack8(cw_[u], cc8); unpack8(gt[u], gg);
#pragma unroll
              for (int e = 0; e < 8; ++e) oo[e] = (cc8[e] * hin[e] + hh[e]) * gelu_tanh(gg[e]);
              v4u w2; w2.x = pkbf(oo[0], oo[1]); w2.y = pkbf(oo[2], oo[3]); w2.z = pkbf(oo[4], oo[5]); w2.w = pkbf(oo[6], oo[7]);
              *(v4u*)(MIX + (size_t)m * 1024 + 512 + c0) = w2; } } }
}

__device__ __forceinline__ void p14_final(const Ctx& F) {
    const int gw = F.vcu * NWAVES + F.wave, NGW = F.G * NWAVES;
    f32x4 gn[4];
#pragma unroll
    for (int j = 0; j < 4; ++j) gn[j] = ((const f32x4*)F.in[I_NORM_FINAL])[F.lane + 64 * j];
    for (int m = gw; m < MTOK; m += NGW) { f32x4* xr = (f32x4*)(F.out + (size_t)m * DM) + F.lane; f32x4 v[4]; float s = 0.f;
#pragma unroll
        for (int j = 0; j < 4; ++j) { v[j] = xr[64 * j]; s += (v[j][0] * v[j][0] + v[j][1] * v[j][1]) + (v[j][2] * v[j][2] + v[j][3] * v[j][3]); }
        const float rs = rsqrtf(wave_sum(s) * (1.0f / 1024.0f) + NORM_EPS);
#pragma unroll
        for (int j = 0; j < 4; ++j) xr[64 * j] = v[j] * rs * gn[j]; }
}


__device__ __forceinline__ f32x4 mfma16_z(const bf16x8 a, const bf16x8 b) { f32x4 d; asm volatile("s_nop 1\n\tv_mfma_f32_16x16x32_bf16 %0, %1, %2, 0\n\ts_nop 9" : "=&v"(d) : "v"(a), "v"(b)); return d; }
__device__ __forceinline__ void mfma16_acc(f32x4& acc, const bf16x8 a, const bf16x8 b) { asm volatile("s_nop 1\n\tv_mfma_f32_16x16x32_bf16 %0, %1, %2, %0\n\ts_nop 9" : "+v"(acc) : "v"(a), "v"(b)); }
__device__ __forceinline__ f32x4 mfma4_z(const float a, const float b) { f32x4 d; asm volatile("s_nop 1\n\tv_mfma_f32_16x16x4_f32 %0, %1, %2, 0\n\ts_nop 13" : "=&v"(d) : "v"(a), "v"(b)); return d; }
typedef short s16x4 __attribute__((ext_vector_type(4)));
#ifndef DSA_RA
#define DSA_RA 1
#endif
#ifndef DSA_RB
#define DSA_RB 1
#endif
#ifndef DSA_RC
#define DSA_RC 1
#endif
#ifndef DSA_RAM
#define DSA_RAM 0
#endif
__device__ __forceinline__ void hist_pick(LAS unsigned* hist, int lane, int need, int& bin, int& above, int& cnt) {
    const v4u h4 = *(const LAS v4u*)(hist + 4 * lane);
    const int t = (int)(h4.x + h4.y + h4.z + h4.w);
    const int pin = wave_prefix_incl(t);
    const int tot = __builtin_amdgcn_readlane(pin, 63);
    const int excl = tot - pin, sfx = excl + t;
    const bool here = (excl < need) && (sfx >= need);
    int b = 0, ab = 0, cn = 0;
    { const int c3 = (int)h4.w, c2 = (int)h4.z, c1 = (int)h4.y, c0 = (int)h4.x;
      if (excl + c3 >= need) { b = 3; ab = excl; cn = c3; }
      else if (excl + c3 + c2 >= need) { b = 2; ab = excl + c3; cn = c2; }
      else if (excl + c3 + c2 + c1 >= need) { b = 1; ab = excl + c3 + c2; cn = c1; }
      else { b = 0; ab = excl + c3 + c2 + c1; cn = c0; } }
    const unsigned long long m = __ballot(here);
    const int src = m ? (__ffsll((long long)m) - 1) : 0;
    bin = __builtin_amdgcn_readlane(4 * lane + b, src); above = __builtin_amdgcn_readlane(ab, src); cnt = __builtin_amdgcn_readlane(cn, src);
}
__device__ __forceinline__ float relu_i(float x) { const int v = __builtin_bit_cast(int, x); return __builtin_bit_cast(float, v > 0 ? v : 0); }
__device__ __forceinline__ void dsa_phase(const Ctx& F) {
    const int lane = F.lane, wave = F.wave, kl = lane & 15, g = lane >> 4;
    LAS unsigned char* SC = F.lds;
    LAS unsigned char* mysc = SC + wave * 10240;
    LAS unsigned* hist = (LAS unsigned*)(F.lds + 81920 + wave * 1024);
    LAS unsigned* idxl = (LAS unsigned*)(F.lds + 90112 + wave * 2048);
    const bf16* Q = (const bf16*)(F.ws + WS_Q); const bf16* KR = (const bf16*)(F.ws + WS_KR); const bf16* Vm = (const bf16*)(F.ws + WS_VT);
    const bf16* IQ = (const bf16*)(F.ws + WS_IQ); const bf16* IK = (const bf16*)(F.ws + WS_IK); const float* IW = (const float*)(F.ws + WS_IW);
    bf16* ATT = (bf16*)(F.ws + WS_R1);
    const int b = F.vcu >> 4, sub = F.vcu & 15;
    const size_t rowb = (size_t)b * SEQ;
    for (int j = 0; j < 8; ++j) {
        const int grp = ((j & 1) ? (15 - sub) : sub) + 16 * j;
        const int adm = ((grp >> 2) + 1) * 64;
        const int qg = grp * 16;
        for (int ra_ = 0; ra_ < DSA_RA; ++ra_) {
          const bf16* iqp = IQ + (((rowb + qg) >> 1) + wave) * 1024 + lane * 8;
          const bf16x8 aq0 = *(const bf16x8*)iqp, aq1 = *(const bf16x8*)(iqp + 512);
          const f32x4 iw = *(const f32x4*)(IW + (rowb + qg + 2 * wave + (g >> 1)) * 8 + 4 * (g & 1));
          const f32x2 w01 = (f32x2){iw[0], iw[1]}, w23 = (f32x2){iw[2], iw[3]};
          const int nt16 = adm >> 4;
          const bf16* ikb = IK + (rowb >> 4) * 1024 + lane * 8;
          LAS unsigned char* dstb = mysc + (g >> 1) * 5120 + kl * 2;
          bf16x8 ka[4][2], kb[4][2];
#define DSA_IKLOAD(K, T0) do { _Pragma("unroll") for (int u = 0; u < 4; ++u) { const int tn = min((T0) + u, nt16 - 1); const bf16* ikp = ikb + (size_t)tn * 1024; K[u][0] = *(const bf16x8*)ikp; K[u][1] = *(const bf16x8*)(ikp + 512); } } while (0)
#define DSA_SCORE4(K, T0) do { f32x4 cc[4]; \
            asm volatile("s_nop 1\n\tv_mfma_f32_16x16x32_bf16 %0, %4, %6, 0\n\tv_mfma_f32_16x16x32_bf16 %1, %4, %8, 0\n\tv_mfma_f32_16x16x32_bf16 %2, %4, %10, 0\n\tv_mfma_f32_16x16x32_bf16 %3, %4, %12, 0\n\t" \
                         "v_mfma_f32_16x16x32_bf16 %0, %5, %7, %0\n\tv_mfma_f32_16x16x32_bf16 %1, %5, %9, %1\n\tv_mfma_f32_16x16x32_bf16 %2, %5, %11, %2\n\tv_mfma_f32_16x16x32_bf16 %3, %5, %13, %3\n\ts_nop 9" \
                         : "=&v"(cc[0]), "=&v"(cc[1]), "=&v"(cc[2]), "=&v"(cc[3]) \
                         : "v"(aq0), "v"(aq1), "v"(K[0][0]), "v"(K[0][1]), "v"(K[1][0]), "v"(K[1][1]), "v"(K[2][0]), "v"(K[2][1]), "v"(K[3][0]), "v"(K[3][1])); \
            DSA_IKLOAD(K, (T0) + 8); \
            _Pragma("unroll") for (int u = 0; u < 4; ++u) { const int t = (T0) + u; \
                const f32x2 r01 = (f32x2){relu_i(cc[u][0]), relu_i(cc[u][1])}, r23 = (f32x2){relu_i(cc[u][2]), relu_i(cc[u][3])}; \
                const f32x2 s2 = r01 * w01 + r23 * w23; const float part = s2[0] + s2[1]; \
                const unsigned pu = __builtin_bit_cast(unsigned, part); \
                const auto sw = __builtin_amdgcn_permlane16_swap(pu, pu, false, false);     \
                float tot = __builtin_bit_cast(float, (unsigned)sw[0]) + __builtin_bit_cast(float, (unsigned)sw[1]); \
                tot = __builtin_amdgcn_fmed3f(tot, -60000.f, 60000.f); \
                const _Float16 hv = (_Float16)tot; \
                *(LAS unsigned short*)(dstb + (t >> 1) * 80 + (t & 1) * 32) = __builtin_bit_cast(unsigned short, hv); } } while (0)
          DSA_IKLOAD(ka, 0); DSA_IKLOAD(kb, 4);
          for (int t0 = 0; t0 < nt16; t0 += 8) {
              DSA_SCORE4(ka, t0);
              if (t0 + 4 < nt16) DSA_SCORE4(kb, t0 + 4);
          }
#undef DSA_IKLOAD
#undef DSA_SCORE4
        }
        int nsel[2];
        for (int rb_ = 0; rb_ < DSA_RB; ++rb_)
#pragma unroll
        for (int qi = 0; qi < 2; ++qi) {
            unsigned mk = 0u;
            const bool live = lane < (adm >> 5);
            if (adm <= 256) { mk = live ? 0xffffffffu : 0u; }
            else {
                const LAS unsigned char* sp = mysc + qi * 5120 + lane * 80;
                const v4u w0 = *(const LAS v4u*)(sp), w1 = *(const LAS v4u*)(sp + 16), w2 = *(const LAS v4u*)(sp + 32), w3 = *(const LAS v4u*)(sp + 48);
                const unsigned ww[16] = {w0.x, w0.y, w0.z, w0.w, w1.x, w1.y, w1.z, w1.w, w2.x, w2.y, w2.z, w2.w, w3.x, w3.y, w3.z, w3.w};
                unsigned u[32];
#pragma unroll
                for (int i = 0; i < 32; ++i) { const unsigned raw = (ww[i >> 1] >> (16 * (i & 1))) & 0xffffu; u[i] = raw ^ ((raw & 0x8000u) ? 0xffffu : 0x8000u); }
                int B1, ab1, c1, B2, ab2, c2;
                *(LAS v4u*)(hist + 4 * lane) = (v4u){0u, 0u, 0u, 0u};
                asm volatile("" ::: "memory");
                if (live) {
#pragma unroll
                    for (int i = 0; i < 32; ++i) __hip_atomic_fetch_add(hist + (u[i] >> 8), 1u, __ATOMIC_RELAXED, __HIP_MEMORY_SCOPE_WORKGROUP); }
                asm volatile("" ::: "memory");
                hist_pick(hist, lane, 256, B1, ab1, c1);
                asm volatile("" ::: "memory");
                *(LAS v4u*)(hist + 4 * lane) = (v4u){0u, 0u, 0u, 0u};
                asm volatile("" ::: "memory");
                if (live) {
#pragma unroll
                    for (int i = 0; i < 32; ++i) if ((int)(u[i] >> 8) == B1) __hip_atomic_fetch_add(hist + (u[i] & 255u), 1u, __ATOMIC_RELAXED, __HIP_MEMORY_SCOPE_WORKGROUP); }
                asm volatile("" ::: "memory");
                hist_pick(hist, lane, 256 - ab1, B2, ab2, c2);
                const unsigned T = ((unsigned)B1 << 8) | (unsigned)B2;
                const int need = 256 - ab1 - ab2;
                if (!live) {
#pragma unroll
                    for (int i = 0; i < 32; ++i) u[i] = 0u; }
                if (need == c2) {
#pragma unroll
                    for (int i = 0; i < 32; ++i) mk |= (u[i] >= T) ? (1u << i) : 0u;
                } else {
                    int ceq = 0;
#pragma unroll
                    for (int i = 0; i < 32; ++i) ceq += (u[i] == T) ? 1 : 0;
                    int run = wave_prefix_incl(ceq) - ceq;
#pragma unroll
                    for (int i = 0; i < 32; ++i) { bool sel = u[i] > T; if (u[i] == T) { sel = run < need; ++run; } mk |= sel ? (1u << i) : 0u; }
                }
            }
            const int cnt = __popc(mk); const int incl = wave_prefix_incl(cnt);
            int off = incl - cnt; unsigned w = mk;
            while (w) { const int i = __ffs((int)w) - 1; idxl[qi * 256 + off] = (unsigned)(32 * lane + i) * 128u; ++off; w &= w - 1u; }
            nsel[qi] = __builtin_amdgcn_readlane(incl, 63);
        }
        asm volatile("" ::: "memory");
        const int vslot = lane >> 3, vch = lane & 7;
        const int ntile = nsel[0] >> 5;
        const unsigned char* Kb = (const unsigned char*)(KR + rowb * 64); const unsigned char* Vb = (const unsigned char*)(Vm + rowb * 64);
        const unsigned vofs = 16u * vch;
        bf16x8 bq[2][2]; f32x4 o[2][4]; float mref[2], lpart[2]; v4u kr[2][4], vr[2][4];
        LAS unsigned char* kbuf = F.lds + (wave < 5 ? 106496 + wave * 4608 : 132096 + (wave - 5) * 4608);
#define DSA_GATHER(T) do { _Pragma("unroll") for (int qi = 0; qi < 2; ++qi) { const LAS unsigned* il2 = idxl + qi * 256 + 32 * (T); \
            _Pragma("unroll") for (int i = 0; i < 4; ++i) { const unsigned oi = il2[vslot + 8 * i] + vofs; kr[qi][i] = *(const v4u*)(Kb + oi); vr[qi][i] = *(const v4u*)(Vb + oi); } } } while (0)
        DSA_GATHER(0);
#pragma unroll
        for (int qi = 0; qi < 2; ++qi) { const size_t qrow = rowb + qg + 2 * wave + qi;
            LAS unsigned char* qb = mysc + qi * 5120;
#pragma unroll
            for (int i = 0; i < 2; ++i) *(LAS v4u*)(qb + (8 * i + (lane >> 3)) * 144 + (lane & 7) * 16) = *(const v4u*)(Q + qrow * 1024 + i * 512 + lane * 8);
#pragma unroll
            for (int ks = 0; ks < 2; ++ks) bq[qi][ks] = *(const LAS bf16x8*)(qb + kl * 144 + g * 16 + 64 * ks);
#pragma unroll
            for (int dt = 0; dt < 4; ++dt) o[qi][dt] = (f32x4){0.f, 0.f, 0.f, 0.f};
            mref[qi] = -1e30f; lpart[qi] = 0.f; }
        asm volatile("s_waitcnt lgkmcnt(0)" ::: "memory");
        for (int tt = 0; tt < ntile; ++tt) {
            bf16x8 kc[2][4];
#pragma unroll
            for (int qi = 0; qi < 2; ++qi) { LAS unsigned char* vbuf = mysc + qi * 5120;
#pragma unroll
                for (int i = 0; i < 4; ++i) { *(LAS v4u*)(vbuf + (vslot + 8 * i) * 160 + vch * 16) = vr[qi][i]; *(LAS v4u*)(kbuf + (vslot + 8 * i) * 144 + vch * 16) = kr[qi][i]; }
                asm volatile("" ::: "memory");
#pragma unroll
                for (int i = 0; i < 4; ++i) kc[qi][i] = *(const LAS bf16x8*)(kbuf + (kl + 16 * (i >> 1)) * 144 + g * 16 + 64 * (i & 1));
                asm volatile("" ::: "memory"); }
            if (tt + 1 < ntile) DSA_GATHER(tt + 1);
            f32x4 cq[4];
            asm volatile("s_nop 1\n\tv_mfma_f32_16x16x32_bf16 %0, %4, %12, 0\n\tv_mfma_f32_16x16x32_bf16 %1, %6, %12, 0\n\tv_mfma_f32_16x16x32_bf16 %2, %8, %14, 0\n\tv_mfma_f32_16x16x32_bf16 %3, %10, %14, 0\n\t"
                         "v_mfma_f32_16x16x32_bf16 %0, %5, %13, %0\n\tv_mfma_f32_16x16x32_bf16 %1, %7, %13, %1\n\tv_mfma_f32_16x16x32_bf16 %2, %9, %15, %2\n\tv_mfma_f32_16x16x32_bf16 %3, %11, %15, %3\n\ts_nop 9"
                         : "=&v"(cq[0]), "=&v"(cq[1]), "=&v"(cq[2]), "=&v"(cq[3])
                         : "v"(kc[0][0]), "v"(kc[0][1]), "v"(kc[0][2]), "v"(kc[0][3]), "v"(kc[1][0]), "v"(kc[1][1]), "v"(kc[1][2]), "v"(kc[1][3]), "v"(bq[0][0]), "v"(bq[0][1]), "v"(bq[1][0]), "v"(bq[1][1]));
            bf16x8 pb[2], vf[2][4];
#pragma unroll
            for (int qi = 0; qi < 2; ++qi) {
                float sv[8]; float tmax = -1e30f;
#pragma unroll
                for (int e = 0; e < 8; ++e) { sv[e] = e < 4 ? cq[2 * qi][e] : cq[2 * qi + 1][e - 4]; tmax = fmaxf(tmax, sv[e]); }
                if (__any(tmax > mref[qi] + 8.0f)) { float mn = fmaxf(mref[qi], tmax); mn = fmaxf(mn, __shfl_xor(mn, 16)); mn = fmaxf(mn, __shfl_xor(mn, 32));
                    const float scl = __builtin_amdgcn_exp2f(mref[qi] - mn);
#pragma unroll
                    for (int dt = 0; dt < 4; ++dt) o[qi][dt] = o[qi][dt] * scl;
                    lpart[qi] *= scl; mref[qi] = mn; }
                float p[8];
#pragma unroll
                for (int e = 0; e < 8; ++e) { p[e] = __builtin_amdgcn_exp2f(sv[e] - mref[qi]); lpart[qi] += p[e]; }
                v4u pw; pw.x = pkbf(p[0], p[1]); pw.y = pkbf(p[2], p[3]); pw.z = pkbf(p[4], p[5]); pw.w = pkbf(p[6], p[7]);
                pb[qi] = __builtin_bit_cast(bf16x8, pw);
                const LAS unsigned char* trb = mysc + qi * 5120 + (4 * g + ((lane & 15) >> 2)) * 160 + (lane & 3) * 8;
#pragma unroll
                for (int dt = 0; dt < 4; ++dt) {
                    const s16x4 va = __builtin_amdgcn_ds_read_tr16_b64_v4i16((LAS s16x4*)(trb + dt * 32));
                    const s16x4 vb = __builtin_amdgcn_ds_read_tr16_b64_v4i16((LAS s16x4*)(trb + 16 * 160 + dt * 32));
                    vf[qi][dt][0] = va[0]; vf[qi][dt][1] = va[1]; vf[qi][dt][2] = va[2]; vf[qi][dt][3] = va[3]; vf[qi][dt][4] = vb[0]; vf[qi][dt][5] = vb[1]; vf[qi][dt][6] = vb[2]; vf[qi][dt][7] = vb[3]; } }
            asm volatile("s_nop 1\n\tv_mfma_f32_16x16x32_bf16 %0, %8, %16, %0\n\tv_mfma_f32_16x16x32_bf16 %1, %9, %16, %1\n\tv_mfma_f32_16x16x32_bf16 %2, %10, %16, %2\n\tv_mfma_f32_16x16x32_bf16 %3, %11, %16, %3\n\t"
                         "v_mfma_f32_16x16x32_bf16 %4, %12, %17, %4\n\tv_mfma_f32_16x16x32_bf16 %5, %13, %17, %5\n\tv_mfma_f32_16x16x32_bf16 %6, %14, %17, %6\n\tv_mfma_f32_16x16x32_bf16 %7, %15, %17, %7\n\ts_nop 9"
                         : "+v"(o[0][0]), "+v"(o[0][1]), "+v"(o[0][2]), "+v"(o[0][3]), "+v"(o[1][0]), "+v"(o[1][1]), "+v"(o[1][2]), "+v"(o[1][3])
                         : "v"(vf[0][0]), "v"(vf[0][1]), "v"(vf[0][2]), "v"(vf[0][3]), "v"(vf[1][0]), "v"(vf[1][1]), "v"(vf[1][2]), "v"(vf[1][3]), "v"(pb[0]), "v"(pb[1]));
        }
#undef DSA_GATHER
#pragma unroll
        for (int qi = 0; qi < 2; ++qi) { const size_t qrow = rowb + qg + 2 * wave + qi;
            float l = lpart[qi]; l += __shfl_xor(l, 16); l += __shfl_xor(l, 32);
            const float inv = 1.0f / l;
            LAS unsigned char* ob = mysc + qi * 5120;
#pragma unroll
            for (int dt = 0; dt < 4; ++dt) { u32x2 w2; w2.x = pkbf(o[qi][dt][0] * inv, o[qi][dt][1] * inv); w2.y = pkbf(o[qi][dt][2] * inv, o[qi][dt][3] * inv);
                *(LAS u32x2*)(ob + kl * 128 + (16 * dt + 4 * g) * 2) = w2; }
#pragma unroll
            for (int i = 0; i < 2; ++i) *(v4u*)(ATT + qrow * 1024 + i * 512 + lane * 8) = *(const LAS v4u*)(ob + i * 1024 + lane * 16); }
    }
}


constexpr size_t CK_BK = 304 * MiB, CK_APP = 368 * MiB, CK_RPP = 400 * MiB, CK_VP = 432 * MiB, CK_W1 = 464 * MiB, CK_PC = 496 * MiB;
constexpr size_t CK_Y0 = 32 * MiB;
constexpr size_t WS_END2 = 512 * MiB;

__device__ __forceinline__ void mtx_n(const f32x4 M0, const f32x4 X0, const f32x4 a0, f32x4& r0) {
    f32x4 d0 = a0;
    asm volatile("s_nop 1\n\tv_mfma_f32_16x16x4_f32 %0, %1, %5, %0\n\tv_mfma_f32_16x16x4_f32 %0, %2, %6, %0\n\tv_mfma_f32_16x16x4_f32 %0, %3, %7, %0\n\tv_mfma_f32_16x16x4_f32 %0, %4, %8, %0\n\ts_nop 13"
                 : "+&v"(d0) : "v"(M0[0]), "v"(M0[1]), "v"(M0[2]), "v"(M0[3]), "v"(X0[0]), "v"(X0[1]), "v"(X0[2]), "v"(X0[3]));
    r0 = d0;
}
__device__ __forceinline__ void mtx_zz(const f32x4 M0, const f32x4 X0, f32x4& r0, const f32x4 M1, const f32x4 X1, f32x4& r1) {
    f32x4 d0; f32x4 d1;
    asm volatile("s_nop 1\n\tv_mfma_f32_16x16x4_f32 %0, %2, %6, 0\n\tv_mfma_f32_16x16x4_f32 %1, %10, %14, 0\n\tv_mfma_f32_16x16x4_f32 %0, %3, %7, %0\n\tv_mfma_f32_16x16x4_f32 %1, %11, %15, %1\n\tv_mfma_f32_16x16x4_f32 %0, %4, %8, %0\n\tv_mfma_f32_16x16x4_f32 %1, %12, %16, %1\n\tv_mfma_f32_16x16x4_f32 %0, %5, %9, %0\n\tv_mfma_f32_16x16x4_f32 %1, %13, %17, %1\n\ts_nop 13"
                 : "=&v"(d0), "=&v"(d1) : "v"(M0[0]), "v"(M0[1]), "v"(M0[2]), "v"(M0[3]), "v"(X0[0]), "v"(X0[1]), "v"(X0[2]), "v"(X0[3]), "v"(M1[0]), "v"(M1[1]), "v"(M1[2]), "v"(M1[3]), "v"(X1[0]), "v"(X1[1]), "v"(X1[2]), "v"(X1[3]));
    r0 = d0; r1 = d1;
}
__device__ __forceinline__ void mtx_nn(const f32x4 M0, const f32x4 X0, const f32x4 a0, f32x4& r0, const f32x4 M1, const f32x4 X1, const f32x4 a1, f32x4& r1) {
    f32x4 d0 = a0; f32x4 d1 = a1;
    asm volatile("s_nop 1\n\tv_mfma_f32_16x16x4_f32 %0, %2, %6, %0\n\tv_mfma_f32_16x16x4_f32 %1, %10, %14, %1\n\tv_mfma_f32_16x16x4_f32 %0, %3, %7, %0\n\tv_mfma_f32_16x16x4_f32 %1, %11, %15, %1\n\tv_mfma_f32_16x16x4_f32 %0, %4, %8, %0\n\tv_mfma_f32_16x16x4_f32 %1, %12, %16, %1\n\tv_mfma_f32_16x16x4_f32 %0, %5, %9, %0\n\tv_mfma_f32_16x16x4_f32 %1, %13, %17, %1\n\ts_nop 13"
                 : "+&v"(d0), "+&v"(d1) : "v"(M0[0]), "v"(M0[1]), "v"(M0[2]), "v"(M0[3]), "v"(X0[0]), "v"(X0[1]), "v"(X0[2]), "v"(X0[3]), "v"(M1[0]), "v"(M1[1]), "v"(M1[2]), "v"(M1[3]), "v"(X1[0]), "v"(X1[1]), "v"(X1[2]), "v"(X1[3]));
    r0 = d0; r1 = d1;
}
__device__ __forceinline__ void mtx_zn(const f32x4 M0, const f32x4 X0, f32x4& r0, const f32x4 M1, const f32x4 X1, const f32x4 a1, f32x4& r1) {
    f32x4 d0; f32x4 d1 = a1;
    asm volatile("s_nop 1\n\tv_mfma_f32_16x16x4_f32 %0, %2, %6, 0\n\tv_mfma_f32_16x16x4_f32 %1, %10, %14, %1\n\tv_mfma_f32_16x16x4_f32 %0, %3, %7, %0\n\tv_mfma_f32_16x16x4_f32 %1, %11, %15, %1\n\tv_mfma_f32_16x16x4_f32 %0, %4, %8, %0\n\tv_mfma_f32_16x16x4_f32 %1, %12, %16, %1\n\tv_mfma_f32_16x16x4_f32 %0, %5, %9, %0\n\tv_mfma_f32_16x16x4_f32 %1, %13, %17, %1\n\ts_nop 13"
                 : "=&v"(d0), "+&v"(d1) : "v"(M0[0]), "v"(M0[1]), "v"(M0[2]), "v"(M0[3]), "v"(X0[0]), "v"(X0[1]), "v"(X0[2]), "v"(X0[3]), "v"(M1[0]), "v"(M1[1]), "v"(M1[2]), "v"(M1[3]), "v"(X1[0]), "v"(X1[1]), "v"(X1[2]), "v"(X1[3]));
    r0 = d0; r1 = d1;
}
__device__ __forceinline__ void mtx_nnz(const f32x4 M0, const f32x4 X0, const f32x4 a0, f32x4& r0, const f32x4 M1, const f32x4 X1, const f32x4 a1, f32x4& r1, const f32x4 M2, const f32x4 X2, f32x4& r2) {
    f32x4 d0 = a0; f32x4 d1 = a1; f32x4 d2;
    asm volatile("s_nop 1\n\tv_mfma_f32_16x16x4_f32 %0, %3, %7, %0\n\tv_mfma_f32_16x16x4_f32 %1, %11, %15, %1\n\tv_mfma_f32_16x16x4_f32 %2, %19, %23, 0\n\tv_mfma_f32_16x16x4_f32 %0, %4, %8, %0\n\tv_mfma_f32_16x16x4_f32 %1, %12, %16, %1\n\tv_mfma_f32_16x16x4_f32 %2, %20, %24, %2\n\tv_mfma_f32_16x16x4_f32 %0, %5, %9, %0\n\tv_mfma_f32_16x16x4_f32 %1, %13, %17, %1\n\tv_mfma_f32_16x16x4_f32 %2, %21, %25, %2\n\tv_mfma_f32_16x16x4_f32 %0, %6, %10, %0\n\tv_mfma_f32_16x16x4_f32 %1, %14, %18, %1\n\tv_mfma_f32_16x16x4_f32 %2, %22, %26, %2\n\ts_nop 13"
                 : "+&v"(d0), "+&v"(d1), "=&v"(d2) : "v"(M0[0]), "v"(M0[1]), "v"(M0[2]), "v"(M0[3]), "v"(X0[0]), "v"(X0[1]), "v"(X0[2]), "v"(X0[3]), "v"(M1[0]), "v"(M1[1]), "v"(M1[2]), "v"(M1[3]), "v"(X1[0]), "v"(X1[1]), "v"(X1[2]), "v"(X1[3]), "v"(M2[0]), "v"(M2[1]), "v"(M2[2]), "v"(M2[3]), "v"(X2[0]), "v"(X2[1]), "v"(X2[2]), "v"(X2[3]));
    r0 = d0; r1 = d1; r2 = d2;
}
__device__ __forceinline__ void mtx_zzz(const f32x4 M0, const f32x4 X0, f32x4& r0, const f32x4 M1, const f32x4 X1, f32x4& r1, const f32x4 M2, const f32x4 X2, f32x4& r2) {
    f32x4 d0; f32x4 d1; f32x4 d2;
    asm volatile("s_nop 1\n\tv_mfma_f32_16x16x4_f32 %0, %3, %7, 0\n\tv_mfma_f32_16x16x4_f32 %1, %11, %15, 0\n\tv_mfma_f32_16x16x4_f32 %2, %19, %23, 0\n\tv_mfma_f32_16x16x4_f32 %0, %4, %8, %0\n\tv_mfma_f32_16x16x4_f32 %1, %12, %16, %1\n\tv_mfma_f32_16x16x4_f32 %2, %20, %24, %2\n\tv_mfma_f32_16x16x4_f32 %0, %5, %9, %0\n\tv_mfma_f32_16x16x4_f32 %1, %13, %17, %1\n\tv_mfma_f32_16x16x4_f32 %2, %21, %25, %2\n\tv_mfma_f32_16x16x4_f32 %0, %6, %10, %0\n\tv_mfma_f32_16x16x4_f32 %1, %14, %18, %1\n\tv_mfma_f32_16x16x4_f32 %2, %22, %26, %2\n\ts_nop 13"
                 : "=&v"(d0), "=&v"(d1), "=&v"(d2) : "v"(M0[0]), "v"(M0[1]), "v"(M0[2]), "v"(M0[3]), "v"(X0[0]), "v"(X0[1]), "v"(X0[2]), "v"(X0[3]), "v"(M1[0]), "v"(M1[1]), "v"(M1[2]), "v"(M1[3]), "v"(X1[0]), "v"(X1[1]), "v"(X1[2]), "v"(X1[3]), "v"(M2[0]), "v"(M2[1]), "v"(M2[2]), "v"(M2[3]), "v"(X2[0]), "v"(X2[1]), "v"(X2[2]), "v"(X2[3]));
    r0 = d0; r1 = d1; r2 = d2;
}
#ifndef PREP_BF16
#define PREP_BF16 0
#endif
__device__ __forceinline__ bf16x8 pk4(const f32x4 v) { v4u w; w.x = pkbf(v[0], v[1]); w.y = pkbf(v[2], v[3]); w.z = 0u; w.w = 0u; return __builtin_bit_cast(bf16x8, w); }
__device__ __forceinline__ f32x4 mtxb(const bf16x8 M, const bf16x8 X, const f32x4 acc) { f32x4 d = acc;
    asm volatile("s_nop 1\n\tv_mfma_f32_16x16x32_bf16 %0, %1, %2, %0\n\ts_nop 9" : "+&v"(d) : "v"(M), "v"(X)); return d; }
__device__ __forceinline__ void mtxb2(const bf16x8 M0, const bf16x8 X0, const f32x4 a0, f32x4& r0, const bf16x8 M1, const bf16x8 X1, const f32x4 a1, f32x4& r1) { f32x4 d0 = a0, d1 = a1;
    asm volatile("s_nop 1\n\tv_mfma_f32_16x16x32_bf16 %0, %2, %3, %0\n\tv_mfma_f32_16x16x32_bf16 %1, %4, %5, %1\n\ts_nop 9" : "+&v"(d0), "+&v"(d1) : "v"(M0), "v"(X0), "v"(M1), "v"(X1)); r0 = d0; r1 = d1; }
__device__ __forceinline__ void mtxb3(const bf16x8 M0, const bf16x8 X0, const f32x4 a0, f32x4& r0, const bf16x8 M1, const bf16x8 X1, const f32x4 a1, f32x4& r1, const bf16x8 M2, const bf16x8 X2, const f32x4 a2, f32x4& r2) { f32x4 d0 = a0, d1 = a1, d2 = a2;
    asm volatile("s_nop 1\n\tv_mfma_f32_16x16x32_bf16 %0, %3, %4, %0\n\tv_mfma_f32_16x16x32_bf16 %1, %5, %6, %1\n\tv_mfma_f32_16x16x32_bf16 %2, %7, %8, %2\n\ts_nop 9" : "+&v"(d0), "+&v"(d1), "+&v"(d2) : "v"(M0), "v"(X0), "v"(M1), "v"(X1), "v"(M2), "v"(X2)); r0 = d0; r1 = d1; r2 = d2; }
__device__ __forceinline__ void unpack4(const u32x2 x, float (&o)[4]) { o[0] = bflo(x.x); o[1] = bfhi(x.x); o[2] = bflo(x.y); o[3] = bfhi(x.y); }

__device__ __forceinline__ void rwkv_chunk_prep(const Ctx& F) {
    const int lane = F.lane, cl = lane & 15, g = lane >> 4;
    LAS unsigned char* L = F.lds + F.wave * 9216;
    LAS unsigned char* LFT = L;
    LAS unsigned char* TL = F.lds + 73728 + F.wave * 4096;
    const bf16* PROJ = (const bf16*)(F.ws + WS_R1);
    unsigned char* dout = (unsigned char*)F.out; float* BONUS = (float*)(F.ws + WS_BONUS);
    const int gw = F.vcu * NWAVES + F.wave;
    const f32x4 z4 = (f32x4){0.f, 0.f, 0.f, 0.f};
    LAS unsigned char* WLS = F.lds + 106496;
    { const int hh = ((gw * 8) >> 7) & 7; const bf16* WLg = (const bf16*)(F.ws + WS_W_LORAT);
#pragma unroll
      for (int i = 0; i < 2; ++i) { const int idx = F.tid + 512 * i, part = idx >> 9, rem = idx & 511;
          *(LAS v4u*)(WLS + idx * 16) = *(const v4u*)(WLg + ((part * 8 + hh) * 512 + rem) * 8); } }
    __syncthreads();
    v4u lfc[4];
#define PREP_LOAD(IT) do { const int task_ = gw * 8 + (IT); const int m0_ = (task_ >> 10) * SEQ + 16 * (task_ & 127); \
        const bf16* pt = PROJ + (size_t)(m0_ + cl) * IN0; \
        _Pragma("unroll") for (int q2 = 0; q2 < 4; ++q2) lfc[q2] = *(const v4u*)(pt + C_WD + 32 * q2 + 8 * g); } while (0)
    PREP_LOAD(0);
    for (int it = 0; it < 8; ++it) {
        const int task = gw * 8 + it;
        const int ck = task & 127, h = (task >> 7) & 7, b = task >> 10;
        const int m0 = b * SEQ + 16 * ck, c0 = h * 64 + 4 * cl;
        float mur[4], muk[4], muv[4], kkc[4], kac[4], rkc[4];
#pragma unroll
        for (int j = 0; j < 4; ++j) { mur[j] = F.in[I_MU][C_R + c0 + j]; muk[j] = F.in[I_MU][C_K + c0 + j]; muv[j] = F.in[I_MU][C_V + c0 + j]; kkc[j] = F.in[I_K_K][c0 + j]; kac[j] = F.in[I_K_A][c0 + j]; rkc[j] = F.in[I_R_K][c0 + j]; }
        u32x2 rq[5], kq[5], vq5[5];
#pragma unroll
        for (int q = 0; q < 5; ++q) { const int m = m0 + 4 * g + q - 1; const bool ok = (m & (SEQ - 1)) != (SEQ - 1) || q > 0;
            const bf16* p = PROJ + (size_t)m * IN0 + c0; rq[q] = (u32x2){0u, 0u}; kq[q] = rq[q]; vq5[q] = rq[q];
            if (ok) { rq[q] = *(const u32x2*)(p + C_R); kq[q] = *(const u32x2*)(p + C_K); vq5[q] = *(const u32x2*)(p + C_V); } }
        float wdec[4][4], alp[4][4];
        { bf16x8 lf[4];
#pragma unroll
          for (int q2 = 0; q2 < 4; ++q2) { const int col = C_WD + 32 * q2 + 8 * g;
              const v4u cur = lfc[q2]; v4u prv;
              prv.x = (unsigned)__builtin_amdgcn_update_dpp(0, (int)cur.x, 0x111, 0xf, 0xf, false); prv.y = (unsigned)__builtin_amdgcn_update_dpp(0, (int)cur.y, 0x111, 0xf, 0xf, false);
              prv.z = (unsigned)__builtin_amdgcn_update_dpp(0, (int)cur.z, 0x111, 0xf, 0xf, false); prv.w = (unsigned)__builtin_amdgcn_update_dpp(0, (int)cur.w, 0x111, 0xf, 0xf, false);
              if (cl == 0 && (m0 & (SEQ - 1)) != 0) prv = *(const v4u*)(PROJ + (size_t)(m0 - 1) * IN0 + col);
              const f32x4 mm0 = *(const f32x4*)(F.in[I_MU] + col), mm1 = *(const f32x4*)(F.in[I_MU] + col + 4);
              float x[8], xp[8], o8[8]; unpack8(cur, x); unpack8(prv, xp);
#pragma unroll
              for (int e2 = 0; e2 < 8; ++e2) { const float s = x[e2] + (xp[e2] - x[e2]) * (e2 < 4 ? mm0[e2] : mm1[e2 - 4]); o8[e2] = q2 < 2 ? tanhf_(s) : s; }
              v4u w; w.x = pkbf(o8[0], o8[1]); w.y = pkbf(o8[2], o8[3]); w.z = pkbf(o8[4], o8[5]); w.w = pkbf(o8[6], o8[7]); lf[q2] = __builtin_bit_cast(bf16x8, w); }
          if (it + 1 < 8) PREP_LOAD(it + 1);
          bf16x8 wdk[4][2], wak[4][2];
#pragma unroll
          for (int j = 0; j < 4; ++j)
#pragma unroll
              for (int ks = 0; ks < 2; ++ks) { wdk[j][ks] = *(const LAS bf16x8*)(WLS + (((j * 2 + ks) * 64) + lane) * 16); wak[j][ks] = *(const LAS bf16x8*)(WLS + 8192 + (((j * 2 + ks) * 64) + lane) * 16); }
          f32x4 dacc[4], aacc[4];
          asm volatile("s_nop 1\n\tv_mfma_f32_16x16x32_bf16 %0, %8, %9, 0\n\tv_mfma_f32_16x16x32_bf16 %1, %8, %11, 0\n\tv_mfma_f32_16x16x32_bf16 %2, %8, %13, 0\n\tv_mfma_f32_16x16x32_bf16 %3, %8, %15, 0\n\t"
                       "v_mfma_f32_16x16x32_bf16 %4, %17, %19, 0\n\tv_mfma_f32_16x16x32_bf16 %5, %17, %21, 0\n\tv_mfma_f32_16x16x32_bf16 %6, %17, %23, 0\n\tv_mfma_f32_16x16x32_bf16 %7, %17, %25, 0\n\t"
                       "v_mfma_f32_16x16x32_bf16 %0, %27, %10, %0\n\tv_mfma_f32_16x16x32_bf16 %1, %27, %12, %1\n\tv_mfma_f32_16x16x32_bf16 %2, %27, %14, %2\n\tv_mfma_f32_16x16x32_bf16 %3, %27, %16, %3\n\t"
                       "v_mfma_f32_16x16x32_bf16 %4, %18, %20, %4\n\tv_mfma_f32_16x16x32_bf16 %5, %18, %22, %5\n\tv_mfma_f32_16x16x32_bf16 %6, %18, %24, %6\n\tv_mfma_f32_16x16x32_bf16 %7, %18, %26, %7\n\ts_nop 9"
                       : "=&v"(dacc[0]), "=&v"(dacc[1]), "=&v"(dacc[2]), "=&v"(dacc[3]), "=&v"(aacc[0]), "=&v"(aacc[1]), "=&v"(aacc[2]), "=&v"(aacc[3])
                       : "v"(lf[0]), "v"(wdk[0][0]), "v"(wdk[0][1]), "v"(wdk[1][0]), "v"(wdk[1][1]), "v"(wdk[2][0]), "v"(wdk[2][1]), "v"(wdk[3][0]), "v"(wdk[3][1]),
                         "v"(lf[2]), "v"(lf[3]), "v"(wak[0][0]), "v"(wak[0][1]), "v"(wak[1][0]), "v"(wak[1][1]), "v"(wak[2][0]), "v"(wak[2][1]), "v"(wak[3][0]), "v"(wak[3][1]), "v"(lf[1]));
          const f32x4 w0v = *(const f32x4*)(F.in[I_W_DECAY0] + c0), abv = *(const f32x4*)(F.in[I_A_BIAS] + c0);
#pragma unroll
          for (int q = 0; q < 4; ++q)
#pragma unroll
              for (int j = 0; j < 4; ++j) { wdec[q][j] = __expf(-0.6065306597126334f * sigmoidf_(dacc[j][q] + w0v[j])); alp[q][j] = sigmoidf_(aacc[j][q] + abv[j]); } }
        float rr[5][4], kk_[5][4], vv[5][4];
#pragma unroll
        for (int q = 0; q < 5; ++q) { unpack4(rq[q], rr[q]); unpack4(kq[q], kk_[q]); unpack4(vq5[q], vv[q]); }
        float Pinc[4][4], Pexc[4][4], PC[4];
#pragma unroll
        for (int j = 0; j < 4; ++j) { const float l0 = wdec[0][j], l1 = l0 * wdec[1][j], l2 = l1 * wdec[2][j], l3 = l2 * wdec[3][j];
            float L0, L1, L2, L3; rows_gather4(l3, L0, L1, L2, L3);
            float E = 1.0f; if (g >= 1) E *= L0; if (g >= 2) E *= L1; if (g >= 3) E *= L2;
            Pexc[0][j] = E; Pinc[0][j] = E * l0; Pexc[1][j] = Pinc[0][j]; Pinc[1][j] = E * l1; Pexc[2][j] = Pinc[1][j]; Pinc[2][j] = E * l2; Pexc[3][j] = Pinc[2][j]; Pinc[3][j] = E * l3;
            PC[j] = (L0 * L1) * (L2 * L3); }
        f32x4 At[4], Rt[4], Vv[4];
        float Bt_[4][4], Kt_[4][4];
#pragma unroll
        for (int q = 0; q < 4; ++q) {
            float kraw[4], ks[4]; float ss = 0.f, bon = 0.f;
#pragma unroll
            for (int j = 0; j < 4; ++j) { ks[j] = kk_[q + 1][j] + (kk_[q][j] - kk_[q + 1][j]) * muk[j]; kraw[j] = ks[j] * kkc[j]; ss += kraw[j] * kraw[j]; }
            ss = row16_sum(ss);
            const float inv = rsqrtf(fmaxf(ss, 1e-24f));
#pragma unroll
            for (int j = 0; j < 4; ++j) { const float rs = rr[q + 1][j] + (rr[q][j] - rr[q + 1][j]) * mur[j], vs = vv[q + 1][j] + (vv[q][j] - vv[q + 1][j]) * muv[j];
                const float kkn = kraw[j] * inv, al = alp[q][j], kmod = ks[j] * (1.0f + (al - 1.0f) * kac[j]), bvec = kkn * al;
                const float ip = __builtin_amdgcn_rcpf(Pinc[q][j]);
                At[j][q] = -kkn * Pexc[q][j]; Rt[j][q] = rs * Pinc[q][j]; Vv[j][q] = vs; Bt_[q][j] = bvec * ip; Kt_[q][j] = kmod * ip; bon += rs * kmod * rkc[j]; }
            bon = row16_sum(bon);
            if (cl == 0) BONUS[(size_t)(m0 + 4 * g + q) * 8 + h] = bon; }
#pragma unroll
        for (int q = 0; q < 4; ++q) { LAS unsigned char* rowp = L + (4 * g + q) * 144 + cl * 8;
            u32x2 w; w.x = pkbf(At[0][q], At[1][q]); w.y = pkbf(At[2][q], At[3][q]); *(LAS u32x2*)(rowp) = w;
            w.x = pkbf(Bt_[q][0], Bt_[q][1]); w.y = pkbf(Bt_[q][2], Bt_[q][3]); *(LAS u32x2*)(rowp + 2304) = w;
            w.x = pkbf(Kt_[q][0], Kt_[q][1]); w.y = pkbf(Kt_[q][2], Kt_[q][3]); *(LAS u32x2*)(rowp + 4608) = w;
            w.x = pkbf(Rt[0][q], Rt[1][q]); w.y = pkbf(Rt[2][q], Rt[3][q]); *(LAS u32x2*)(rowp + 6912) = w; }
        const size_t cidx = (size_t)task;
        { v4u* BKo = (v4u*)(F.ws + CK_BK) + cidx * 256; float* PCo = (float*)(F.ws + CK_PC) + cidx * 64;
#pragma unroll
          for (int j = 0; j < 4; ++j) { v4u bk; bk.x = pkbf(Bt_[0][j] * PC[j], Bt_[1][j] * PC[j]); bk.y = pkbf(Bt_[2][j] * PC[j], Bt_[3][j] * PC[j]);
              bk.z = pkbf(Kt_[0][j] * PC[j], Kt_[1][j] * PC[j]); bk.w = pkbf(Kt_[2][j] * PC[j], Kt_[3][j] * PC[j]); BKo[j * 64 + lane] = bk;
              if (g == 0) PCo[j * 16 + cl] = PC[j]; } }
        asm volatile("s_waitcnt lgkmcnt(0)" ::: "memory");
        f32x4 Nab, NabT, Nak, Mbr, Mkr;
        { const LAS unsigned char* rp = L + cl * 144 + g * 16;
          const bf16x8 a0 = *(const LAS bf16x8*)(rp), a1 = *(const LAS bf16x8*)(rp + 64), b0 = *(const LAS bf16x8*)(rp + 2304), b1 = *(const LAS bf16x8*)(rp + 2304 + 64),
                       k0 = *(const LAS bf16x8*)(rp + 4608), k1 = *(const LAS bf16x8*)(rp + 4608 + 64), r0 = *(const LAS bf16x8*)(rp + 6912), r1 = *(const LAS bf16x8*)(rp + 6912 + 64);
          Nab = mfma16_z(b0, a0) + mfma16_z(b1, a1);
          NabT = mfma16_z(a0, b0) + mfma16_z(a1, b1);
          Nak = mfma16_z(k0, a0) + mfma16_z(k1, a1);
          Mbr = mfma16_z(b0, r0) + mfma16_z(b1, r1);
          Mkr = mfma16_z(k0, r0) + mfma16_z(k1, r1); }
        f32x4 T, TT;
#pragma unroll
        for (int e = 0; e < 4; ++e) { const int row = 4 * g + e;
            Nab[e] = row < cl ? Nab[e] : 0.f; Nak[e] = row < cl ? Nak[e] : 0.f; Mbr[e] = row <= cl ? Mbr[e] : 0.f; Mkr[e] = row <= cl ? Mkr[e] : 0.f;
            NabT[e] = cl < row ? NabT[e] : 0.f;
            T[e] = Nab[e] + (row == cl ? 1.f : 0.f); TT[e] = NabT[e] + (row == cl ? 1.f : 0.f); }
        { f32x4 N2, N2T, T2, TT2, N4, N4T, T4, TT4, N8;
          mtx_zz(NabT, Nab, N2, Nab, NabT, N2T);
          mtx_nn(TT, N2, T, T2, N2, TT, TT, TT2);
          mtx_zz(N2T, N2, N4, N2, N2T, N4T);
          mtx_nnz(TT2, N4, T2, T4, N4, TT2, TT2, TT4, N4T, N4, N8);
          { f32x4 Tn; mtx_n(TT4, N8, T4, Tn); T = Tn; } }
        bf16* APP = (bf16*)(F.ws + CK_APP) + cidx * 1024; bf16* RPP = (bf16*)(F.ws + CK_RPP) + cidx * 1024;
        u32x2* VPo = (u32x2*)(F.ws + CK_VP) + cidx * 256; u32x2* W1o = (u32x2*)(F.ws + CK_W1) + cidx * 256; u32x2* Y0o = (u32x2*)(dout + CK_Y0) + cidx * 256;
#if PREP_BF16
        const bf16x8 Tb = pk4(T), Nakb = pk4(Nak), Mkrb = pk4(Mkr), Mbrb = pk4(Mbr);
#endif
#pragma unroll
        for (int j = 0; j < 4; ++j) {
            f32x4 App, W1T, Y0a, W1pp, Rpp;
#if PREP_BF16
            const bf16x8 vb = pk4(Vv[j]);
            mtxb3(Tb, pk4(At[j]), z4, App, Nakb, vb, z4, W1T, Mkrb, vb, z4, Y0a);
            mtxb2(Tb, pk4(W1T), z4, W1pp, Mbrb, pk4(App), Rt[j], Rpp);
            const f32x4 Y0 = mtxb(Mbrb, pk4(W1pp), Y0a);
#else
            mtx_zzz(T, At[j], App, Nak, Vv[j], W1T, Mkr, Vv[j], Y0a);
            mtx_zn(T, W1T, W1pp, Mbr, App, Rt[j], Rpp);
            f32x4 Y0; mtx_n(Mbr, W1pp, Y0a, Y0);
#endif
            const int pos = (j >> 1) * 32 + (cl >> 2) * 8 + (cl & 3) + 4 * (j & 1);
#pragma unroll
            for (int e = 0; e < 4; ++e) { *(LAS unsigned short*)(TL + ((4 * g + e) * 64 + pos) * 2) = (unsigned short)(pkbf(App[e], 0.f) & 0xffffu); *(LAS unsigned short*)(TL + 2048 + ((4 * g + e) * 64 + pos) * 2) = (unsigned short)(pkbf(Rpp[e], 0.f) & 0xffffu); }
            u32x2 w; w.x = pkbf(Vv[j][0], Vv[j][1]); w.y = pkbf(Vv[j][2], Vv[j][3]); VPo[j * 64 + lane] = w;
            w.x = pkbf(W1pp[0], W1pp[1]); w.y = pkbf(W1pp[2], W1pp[3]); W1o[j * 64 + lane] = w;
            w.x = pkbf(Y0[0], Y0[1]); w.y = pkbf(Y0[2], Y0[3]); Y0o[j * 64 + lane] = w;
        }
        asm volatile("s_waitcnt lgkmcnt(0)" ::: "memory");
        { const int rw = lane >> 3, chn = lane & 7;
#pragma unroll
          for (int hh = 0; hh < 2; ++hh) { const int row = rw + 8 * hh;
              *(v4u*)(APP + row * 64 + 8 * chn) = *(const LAS v4u*)(TL + (row * 64 + 8 * chn) * 2);
              *(v4u*)(RPP + row * 64 + 8 * chn) = *(const LAS v4u*)(TL + 2048 + (row * 64 + 8 * chn) * 2); } }
        asm volatile("s_waitcnt lgkmcnt(0)" ::: "memory");
    }
}

#undef PREP_LOAD
constexpr int CKS_SLOT = 12288, CKS_RPP = 2048, CKS_BK = 4096, CKS_P8 = 8192, CKS_P9 = 9216;
#define CKS_BAR() do { asm volatile("" ::: "memory"); __builtin_amdgcn_s_barrier(); asm volatile("" ::: "memory"); } while (0)
__device__ __forceinline__ void rwkv_chunk_seq(const Ctx& F, int bh, int pair, int lru_task) {
    const int lane = F.lane, wave = F.wave, i16 = lane & 15, g = lane >> 4;
    const int b = bh >> 3, h = bh & 7;
    const unsigned char* dout = (const unsigned char*)F.out;
    const size_t cbase = (size_t)bh * 128;
    LAS unsigned char* ring = F.lds;
    if (wave < 2) {
        const int vq = 2 * pair + wave, vo = wave * 2048;
        bf16* Y = (bf16*)(F.ws + WS_XB) + (size_t)b * SEQ * 1024 + h * 64 + 4 * i16 + vq;
        f32x4 St[4];
#pragma unroll
        for (int j = 0; j < 4; ++j) St[j] = (f32x4){0.f, 0.f, 0.f, 0.f};
        for (int c = 0; c < 128; ++c) {
            CKS_BAR();
            const LAS unsigned char* slot = ring + (c & 7) * CKS_SLOT;
            const bf16x8 cap0 = *(const LAS bf16x8*)(slot + i16 * 128 + g * 16), cap1 = *(const LAS bf16x8*)(slot + i16 * 128 + 64 + g * 16);
            const bf16x8 crp0 = *(const LAS bf16x8*)(slot + CKS_RPP + i16 * 128 + g * 16), crp1 = *(const LAS bf16x8*)(slot + CKS_RPP + i16 * 128 + 64 + g * 16);
            const bf16x8 cbk0 = *(const LAS bf16x8*)(slot + CKS_BK + lane * 16), cbk1 = *(const LAS bf16x8*)(slot + CKS_BK + 1024 + lane * 16),
                         cbk2 = *(const LAS bf16x8*)(slot + CKS_BK + 2048 + lane * 16), cbk3 = *(const LAS bf16x8*)(slot + CKS_BK + 3072 + lane * 16);
            const f32x4 cpc0 = *(const LAS f32x4*)(slot + CKS_P8 + g * 16), cpc1 = *(const LAS f32x4*)(slot + CKS_P8 + 64 + g * 16),
                        cpc2 = *(const LAS f32x4*)(slot + CKS_P8 + 128 + g * 16), cpc3 = *(const LAS f32x4*)(slot + CKS_P8 + 192 + g * 16);
            const u32x2 cvp = *(const LAS u32x2*)(slot + CKS_P8 + vo + 256 + lane * 8), cw1 = *(const LAS u32x2*)(slot + CKS_P9 + vo + lane * 8), cy0 = *(const LAS u32x2*)(slot + CKS_P9 + vo + 512 + lane * 8);
            v4u s0, s1; s0.x = pkbf(St[0][0], St[0][1]); s0.y = pkbf(St[0][2], St[0][3]); s0.z = pkbf(St[1][0], St[1][1]); s0.w = pkbf(St[1][2], St[1][3]);
            s1.x = pkbf(St[2][0], St[2][1]); s1.y = pkbf(St[2][2], St[2][3]); s1.z = pkbf(St[3][0], St[3][1]); s1.w = pkbf(St[3][2], St[3][3]);
            const bf16x8 sf0 = __builtin_bit_cast(bf16x8, s0), sf1 = __builtin_bit_cast(bf16x8, s1);
            f32x4 u0, u1, y0, y1;
            asm volatile("s_nop 1\n\tv_mfma_f32_16x16x32_bf16 %0, %4, %8, 0\n\tv_mfma_f32_16x16x32_bf16 %1, %5, %9, 0\n\tv_mfma_f32_16x16x32_bf16 %2, %6, %8, 0\n\tv_mfma_f32_16x16x32_bf16 %3, %7, %9, 0\n\ts_nop 9"
                         : "=&v"(u0), "=&v"(u1), "=&v"(y0), "=&v"(y1) : "v"(cap0), "v"(cap1), "v"(crp0), "v"(crp1), "v"(sf0), "v"(sf1));
            const f32x4 UT = ((f32x4){bflo(cw1.x), bfhi(cw1.x), bflo(cw1.y), bfhi(cw1.y)} + u0) + u1;
            const f32x4 YT = ((f32x4){bflo(cy0.x), bfhi(cy0.x), bflo(cy0.y), bfhi(cy0.y)} + y0) + y1;
            v4u uv; uv.x = pkbf(UT[0], UT[1]); uv.y = pkbf(UT[2], UT[3]); uv.z = cvp.x; uv.w = cvp.y;
            const bf16x8 uvf = __builtin_bit_cast(bf16x8, uv);
            f32x4 d0, d1, d2, d3;
            asm volatile("s_nop 1\n\tv_mfma_f32_16x16x32_bf16 %0, %4, %8, 0\n\tv_mfma_f32_16x16x32_bf16 %1, %5, %8, 0\n\tv_mfma_f32_16x16x32_bf16 %2, %6, %8, 0\n\tv_mfma_f32_16x16x32_bf16 %3, %7, %8, 0\n\ts_nop 9"
                         : "=&v"(d0), "=&v"(d1), "=&v"(d2), "=&v"(d3) : "v"(cbk0), "v"(cbk1), "v"(cbk2), "v"(cbk3), "v"(uvf));
            St[0] = St[0] * cpc0 + d0; St[1] = St[1] * cpc1 + d1; St[2] = St[2] * cpc2 + d2; St[3] = St[3] * cpc3 + d3;
#pragma unroll
            for (int e = 0; e < 4; ++e) Y[(size_t)(16 * c + 4 * g + e) * 1024] = (bf16)(pkbf(YT[e], 0.f) & 0xffffu);
        }
    } else if (wave <= 5) {
        const int kk = wave - 2;
        const unsigned char* gAPP = F.ws + CK_APP + cbase * 2048 + lane * 16; const unsigned char* gRPP = F.ws + CK_RPP + cbase * 2048 + lane * 16;
        const unsigned char* gBK = F.ws + CK_BK + cbase * 4096 + lane * 16;
        const unsigned char* gPC = F.ws + CK_PC + cbase * 256; const unsigned char* gVP = F.ws + CK_VP + cbase * 2048 + pair * 1024;
        const unsigned char* gW1 = F.ws + CK_W1 + cbase * 2048 + pair * 1024; const unsigned char* gY0 = dout + CK_Y0 + cbase * 2048 + pair * 1024;
        const unsigned char* g8 = lane < 16 ? gPC + lane * 16 : (lane < 48 ? gVP + (lane - 16) * 16 : gPC); const size_t st8 = (lane >= 16 && lane < 48) ? 2048 : 256;
        const unsigned char* g9 = lane < 32 ? gW1 + lane * 16 : gY0 + (lane - 32) * 16;
        const unsigned char* g10 = (lane >= 16 && lane < 48) ? gVP + 512 + (lane - 16) * 16 : gPC; const size_t st10 = (lane >= 16 && lane < 48) ? 2048 : 256;
        const unsigned char* g11 = lane < 32 ? gW1 + 512 + lane * 16 : gY0 + 512 + (lane - 32) * 16;
        v4u r[12];
#define CKS_LOAD(c) do { const size_t c2 = (size_t)(c) * 2048, c4 = (size_t)(c) * 4096; \
        r[0] = *(const v4u*)(gAPP + c2); r[1] = *(const v4u*)(gAPP + c2 + 1024); r[2] = *(const v4u*)(gRPP + c2); r[3] = *(const v4u*)(gRPP + c2 + 1024); \
        r[4] = *(const v4u*)(gBK + c4); r[5] = *(const v4u*)(gBK + c4 + 1024); r[6] = *(const v4u*)(gBK + c4 + 2048); r[7] = *(const v4u*)(gBK + c4 + 3072); \
        r[8] = *(const v4u*)(g8 + (size_t)(c) * st8); r[9] = *(const v4u*)(g9 + c2); r[10] = *(const v4u*)(g10 + (size_t)(c) * st10); r[11] = *(const v4u*)(g11 + c2); } while (0)
        CKS_LOAD(kk);
        for (int c = 0; c < 128; ++c) {
            if ((c & 3) == kk) { LAS unsigned char* slot = ring + (c & 7) * CKS_SLOT + lane * 16;
#pragma unroll
                for (int i = 0; i < 12; ++i) *(LAS v4u*)(slot + i * 1024) = r[i];
                asm volatile("s_waitcnt lgkmcnt(0)" ::: "memory"); }
            CKS_BAR();
            if ((c & 3) == kk && c + 4 < 128) CKS_LOAD(c + 4);
        }
#undef CKS_LOAD
    } else if (wave == 7 && lru_task >= 0) {
        const int lb = lru_task >> 3, lc = (lru_task & 7) * 64 + lane;
        const float* PS = (const float*)(F.ws + WS_LRUPS) + (size_t)lb * 128 * 1024 + lc; float* HIN = (float*)(F.ws + WS_HIN) + (size_t)lb * 128 * 512 + lc;
        float hst = 0.f; float p = PS[0], s = PS[512];
        for (int c = 0; c < 128; ++c) {
            const int cn = c + 1 < 128 ? c + 1 : c; const float np = PS[(size_t)cn * 1024], ns = PS[(size_t)cn * 1024 + 512];
            HIN[(size_t)c * 512] = hst; hst = p * hst + s;
            CKS_BAR();
            p = np; s = ns;
        }
    } else {
        for (int c = 0; c < 128; ++c) CKS_BAR();
    }
}

#ifndef P2_RR
#define P2_RR 1
#define P2_RL 1
#endif
__device__ __forceinline__ void p2_token_local(const Ctx& F) {
    const int lane = F.lane, tl = lane & 15, g = lane >> 4;
    const int gw = F.vcu * NWAVES + F.wave, NGW = F.G * NWAVES;
    const bf16* PROJ = (const bf16*)(F.ws + WS_R1);
    const bf16* WL = (const bf16*)(F.ws + WS_W_LORAT); const bf16* WG = (const bf16*)(F.ws + WS_W_GATET);
    bf16* Gg = (bf16*)((unsigned char*)F.out + DO_G);
    bf16* LRUA1 = (bf16*)((unsigned char*)F.out + DO_LRUA1); bf16* LRUX = (bf16*)((unsigned char*)F.out + DO_LRUX);
    const float* mu = F.in[I_MU]; const float* LAMSP = (const float*)(F.ws + WS_ROPE + 512 * 1024);
    LAS unsigned char* LW = F.lds + F.wave * 16384;
    LAS unsigned char* LFT = LW;
    LAS unsigned char* CVT = LW + 4864;
    LAS unsigned char* OST = LW + 10496;
    const int r8 = lane >> 3, pc8 = lane & 7;
    LAS float* CT = (LAS float*)(F.lds + EPI_LDS_OFF);
    for (int i = F.tid; i < 8 * 512; i += NWAVES * 64) { const int kind = i >> 9, c = i & 511;
        CT[i] = kind < 4 ? F.in[I_CONV_W][kind * 512 + c] : (kind == 4 ? F.in[I_CONV_B][c] : (kind == 5 ? F.in[I_B_RGATE][c] : (kind == 6 ? F.in[I_B_IGATE][c] : LAMSP[c]))); }
    __syncthreads();
    for (int tile = gw; tile < MTOK / 16; tile += NGW) {
        const int m0 = tile * 16, m = m0 + tl, t = m & (SEQ - 1), t0 = m0 & (SEQ - 1);
        const bf16* p = PROJ + (size_t)m * IN0;
        v4u cv[3];
#define P2_CVLOAD(H) do { _Pragma("unroll") for (int i = 0; i < 3; ++i) { const int row = r8 + 8 * i; cv[i] = (v4u){0u, 0u, 0u, 0u}; \
            if (row < 19 && t0 + row >= 3) cv[i] = *(const v4u*)(PROJ + (size_t)(m0 + row - 3) * IN0 + C_LX + 64 * (H) + 8 * pc8); } } while (0)
        P2_CVLOAD(0);
        { const int r4 = lane >> 4, pc = lane & 15;
#pragma unroll
          for (int i = 0; i < 5; ++i) { const int row = r4 + 4 * i; v4u v = (v4u){0u, 0u, 0u, 0u};
              if (row < 17 && (row > 0 || t0 > 0)) v = *(const v4u*)(PROJ + (size_t)(m0 + row - 1) * IN0 + C_WD + 128 + 8 * pc);
              if (row < 17) *(LAS v4u*)(LFT + row * 272 + pc * 16) = v; } }
        asm volatile("" ::: "memory");
        bf16x8 lf[4];
#pragma unroll
        for (int q = 4; q < 8; ++q) { const int col = C_WD + 32 * q + 8 * g;
            const v4u cur = *(const LAS v4u*)(LFT + (tl + 1) * 272 + (32 * (q - 4) + 8 * g) * 2), prv = *(const LAS v4u*)(LFT + tl * 272 + (32 * (q - 4) + 8 * g) * 2);
            const f32x4 m0 = *(const f32x4*)(mu + col), m1 = *(const f32x4*)(mu + col + 4);
            float x[8], xp[8], o[8]; unpack8(cur, x); unpack8(prv, xp);
#pragma unroll
            for (int e = 0; e < 8; ++e) { const float s = x[e] + (xp[e] - x[e]) * (e < 4 ? m0[e] : m1[e - 4]); o[e] = sigmoidf_(s); }
            v4u w; w.x = pkbf(o[0], o[1]); w.y = pkbf(o[2], o[3]); w.z = pkbf(o[4], o[5]); w.w = pkbf(o[6], o[7]); lf[q - 4] = __builtin_bit_cast(bf16x8, w); }
        for (int rr_ = 0; rr_ < P2_RR; ++rr_)
#pragma nounroll
        for (int grp = 0; grp < 8; ++grp) {
            bf16x8 wg_[4][4];
#pragma unroll
            for (int ct = 0; ct < 4; ++ct)
#pragma unroll
                for (int ks = 0; ks < 4; ++ks) wg_[ct][ks] = *(const bf16x8*)(WL + 65536 + ((grp * 4 + ct) * 4 + ks) * 512 + lane * 8);
            { f32x4 acc[4];
              asm volatile("s_nop 1\n\tv_mfma_f32_16x16x32_bf16 %0, %4, %20, 0\n\tv_mfma_f32_16x16x32_bf16 %1, %8, %20, 0\n\tv_mfma_f32_16x16x32_bf16 %2, %12, %20, 0\n\tv_mfma_f32_16x16x32_bf16 %3, %16, %20, 0\n\tv_mfma_f32_16x16x32_bf16 %0, %5, %21, %0\n\tv_mfma_f32_16x16x32_bf16 %1, %9, %21, %1\n\tv_mfma_f32_16x16x32_bf16 %2, %13, %21, %2\n\tv_mfma_f32_16x16x32_bf16 %3, %17, %21, %3\n\tv_mfma_f32_16x16x32_bf16 %0, %6, %22, %0\n\tv_mfma_f32_16x16x32_bf16 %1, %10, %22, %1\n\tv_mfma_f32_16x16x32_bf16 %2, %14, %22, %2\n\tv_mfma_f32_16x16x32_bf16 %3, %18, %22, %3\n\tv_mfma_f32_16x16x32_bf16 %0, %7, %23, %0\n\tv_mfma_f32_16x16x32_bf16 %1, %11, %23, %1\n\tv_mfma_f32_16x16x32_bf16 %2, %15, %23, %2\n\tv_mfma_f32_16x16x32_bf16 %3, %19, %23, %3\n\ts_nop 9"
                  : "=&v"(acc[0]), "=&v"(acc[1]), "=&v"(acc[2]), "=&v"(acc[3])
                  : "v"(wg_[0][0]), "v"(wg_[0][1]), "v"(wg_[0][2]), "v"(wg_[0][3]), "v"(wg_[1][0]), "v"(wg_[1][1]), "v"(wg_[1][2]), "v"(wg_[1][3]), "v"(wg_[2][0]), "v"(wg_[2][1]), "v"(wg_[2][2]), "v"(wg_[2][3]), "v"(wg_[3][0]), "v"(wg_[3][1]), "v"(wg_[3][2]), "v"(wg_[3][3]), "v"(lf[0]), "v"(lf[1]), "v"(lf[2]), "v"(lf[3]));
#pragma unroll
              for (int ct = 0; ct < 4; ++ct) { u32x2 w; w.x = pkbf(acc[ct][0], acc[ct][1]); w.y = pkbf(acc[ct][2], acc[ct][3]); *(LAS u32x2*)(OST + tl * 144 + (16 * ct + 4 * g) * 2) = w; }
              asm volatile("" ::: "memory");
#pragma unroll
              for (int i = 0; i < 2; ++i) { const int row = r8 + 8 * i; *(v4u*)(Gg + (size_t)(m0 + row) * 512 + 64 * grp + 8 * pc8) = *(const LAS v4u*)(OST + row * 144 + pc8 * 16); }
              asm volatile("" ::: "memory"); }
        }
        for (int rl_ = 0; rl_ < P2_RL; ++rl_)
#pragma nounroll
        for (int h = 0; h < 8; ++h) {
            bf16x8 wa[8][2]; f32x4 acc[8];
#pragma unroll
            for (int ct = 0; ct < 4; ++ct)
#pragma unroll
                for (int ks = 0; ks < 2; ++ks) { wa[ct][ks] = *(const bf16x8*)(WG + (((h * 2) * 4 + ct) * 2 + ks) * 512 + lane * 8); wa[4 + ct][ks] = *(const bf16x8*)(WG + (((h * 2 + 1) * 4 + ct) * 2 + ks) * 512 + lane * 8); }
#pragma unroll
            for (int i = 0; i < 3; ++i) { const int row = r8 + 8 * i; if (row < 19) *(LAS v4u*)(CVT + row * 144 + pc8 * 16) = cv[i]; }
            asm volatile("" ::: "memory");
            if (h + 1 < 8) P2_CVLOAD(h + 1);
            f32x4 xc_[4], br_[4], bi_[4], sp_[4];
#pragma unroll
            for (int ct = 0; ct < 4; ++ct) { const int ch = 64 * h + 16 * ct + 4 * g;
                f32x4 xc = *(const LAS f32x4*)(CT + 4 * 512 + ch);
#pragma unroll
                for (int j = 0; j < 4; ++j) { const u32x2 x = *(const LAS u32x2*)(CVT + (tl + j) * 144 + (16 * ct + 4 * g) * 2); const f32x4 w4 = *(const LAS f32x4*)(CT + j * 512 + ch);
                        xc[0] += w4[0] * bflo(x.x); xc[1] += w4[1] * bfhi(x.x); xc[2] += w4[2] * bflo(x.y); xc[3] += w4[3] * bfhi(x.y); }
                xc_[ct] = xc; br_[ct] = *(const LAS f32x4*)(CT + 5 * 512 + ch); bi_[ct] = *(const LAS f32x4*)(CT + 6 * 512 + ch); sp_[ct] = *(const LAS f32x4*)(CT + 7 * 512 + ch); }
            bf16x8 xf[2];
#pragma unroll
            for (int ks = 0; ks < 2; ++ks) { v4u w; w.x = pkbf(xc_[2 * ks][0], xc_[2 * ks][1]); w.y = pkbf(xc_[2 * ks][2], xc_[2 * ks][3]); w.z = pkbf(xc_[2 * ks + 1][0], xc_[2 * ks + 1][1]); w.w = pkbf(xc_[2 * ks + 1][2], xc_[2 * ks + 1][3]);
                xf[ks] = __builtin_bit_cast(bf16x8, w); }
            asm volatile("s_nop 1\n\tv_mfma_f32_16x16x32_bf16 %0, %8, %24, 0\n\tv_mfma_f32_16x16x32_bf16 %1, %10, %24, 0\n\tv_mfma_f32_16x16x32_bf16 %2, %12, %24, 0\n\tv_mfma_f32_16x16x32_bf16 %3, %14, %24, 0\n\tv_mfma_f32_16x16x32_bf16 %4, %16, %24, 0\n\tv_mfma_f32_16x16x32_bf16 %5, %18, %24, 0\n\tv_mfma_f32_16x16x32_bf16 %6, %20, %24, 0\n\tv_mfma_f32_16x16x32_bf16 %7, %22, %24, 0\n\tv_mfma_f32_16x16x32_bf16 %0, %9, %25, %0\n\tv_mfma_f32_16x16x32_bf16 %1, %11, %25, %1\n\tv_mfma_f32_16x16x32_bf16 %2, %13, %25, %2\n\tv_mfma_f32_16x16x32_bf16 %3, %15, %25, %3\n\tv_mfma_f32_16x16x32_bf16 %4, %17, %25, %4\n\tv_mfma_f32_16x16x32_bf16 %5, %19, %25, %5\n\tv_mfma_f32_16x16x32_bf16 %6, %21, %25, %6\n\tv_mfma_f32_16x16x32_bf16 %7, %23, %25, %7\n\ts_nop 9"
                : "=&v"(acc[0]), "=&v"(acc[1]), "=&v"(acc[2]), "=&v"(acc[3]), "=&v"(acc[4]), "=&v"(acc[5]), "=&v"(acc[6]), "=&v"(acc[7])
                : "v"(wa[0][0]), "v"(wa[0][1]), "v"(wa[1][0]), "v"(wa[1][1]), "v"(wa[2][0]), "v"(wa[2][1]), "v"(wa[3][0]), "v"(wa[3][1]), "v"(wa[4][0]), "v"(wa[4][1]), "v"(wa[5][0]), "v"(wa[5][1]), "v"(wa[6][0]), "v"(wa[6][1]), "v"(wa[7][0]), "v"(wa[7][1]), "v"(xf[0]), "v"(xf[1]));
#pragma unroll
            for (int ct = 0; ct < 4; ++ct) { const f32x4 xc = xc_[ct], br = br_[ct], bi = bi_[ct], sp8 = sp_[ct];
                float a1[4], xi[4];
#pragma unroll
                for (int e = 0; e < 4; ++e) { const float rg = sigmoidf_(acc[ct][e] + br[e]), ig = sigmoidf_(acc[4 + ct][e] + bi[e]);
                    const float la = sp8[e] * rg; float A = 1.0f - one_minus_exp(la), X = xc[e] * ig * __builtin_amdgcn_sqrtf(fmaxf(one_minus_exp(2.0f * la), 0.f));
                    { float Xp, Ap;
                      Xp = __builtin_bit_cast(float, __builtin_amdgcn_update_dpp(0, __builtin_bit_cast(int, X), 0x111, 0xf, 0xf, false)); Ap = __builtin_bit_cast(float, __builtin_amdgcn_update_dpp(0x3f800000, __builtin_bit_cast(int, A), 0x111, 0xf, 0xf, false)); X = A * Xp + X; A = A * Ap;
                      Xp = __builtin_bit_cast(float, __builtin_amdgcn_update_dpp(0, __builtin_bit_cast(int, X), 0x112, 0xf, 0xf, false)); Ap = __builtin_bit_cast(float, __builtin_amdgcn_update_dpp(0x3f800000, __builtin_bit_cast(int, A), 0x112, 0xf, 0xf, false)); X = A * Xp + X; A = A * Ap;
                      Xp = __builtin_bit_cast(float, __builtin_amdgcn_update_dpp(0, __builtin_bit_cast(int, X), 0x114, 0xf, 0xf, false)); Ap = __builtin_bit_cast(float, __builtin_amdgcn_update_dpp(0x3f800000, __builtin_bit_cast(int, A), 0x114, 0xf, 0xf, false)); X = A * Xp + X; A = A * Ap;
                      Xp = __builtin_bit_cast(float, __builtin_amdgcn_update_dpp(0, __builtin_bit_cast(int, X), 0x118, 0xf, 0xf, false)); Ap = __builtin_bit_cast(float, __builtin_amdgcn_update_dpp(0x3f800000, __builtin_bit_cast(int, A), 0x118, 0xf, 0xf, false)); X = A * Xp + X; A = A * Ap; }
                    a1[e] = A; xi[e] = X; }
                if (tl == 15) { float* ps = (float*)(F.ws + WS_LRUPS) + (size_t)tile * 1024 + 64 * h + 16 * ct + 4 * g;
                    *(f32x4*)ps = (f32x4){a1[0], a1[1], a1[2], a1[3]}; *(f32x4*)(ps + 512) = (f32x4){xi[0], xi[1], xi[2], xi[3]}; }
                u32x2 w; w.x = pkbf(a1[0], a1[1]); w.y = pkbf(a1[2], a1[3]); *(LAS u32x2*)(OST + tl * 144 + (16 * ct + 4 * g) * 2) = w;
                w.x = pkbf(xi[0], xi[1]); w.y = pkbf(xi[2], xi[3]); *(LAS u32x2*)(OST + 2304 + tl * 144 + (16 * ct + 4 * g) * 2) = w; }
            asm volatile("" ::: "memory");
#pragma unroll
            for (int i = 0; i < 2; ++i) { const int row = r8 + 8 * i;
                *(v4u*)(LRUA1 + (size_t)(m0 + row) * 512 + 64 * h + 8 * pc8) = *(const LAS v4u*)(OST + row * 144 + pc8 * 16);
                *(v4u*)(LRUX + (size_t)(m0 + row) * 512 + 64 * h + 8 * pc8) = *(const LAS v4u*)(OST + 2304 + row * 144 + pc8 * 16); }
            asm volatile("" ::: "memory");
        }
#undef P2_CVLOAD
    }
}

#ifndef MK_SINGLE
#define MK_SINGLE 1
#endif
#ifndef GEMM_WGM_WIDE
#define GEMM_WGM_WIDE 4
#endif
#ifndef GEMM_WGM_NARROW
#define GEMM_WGM_NARROW 8
#endif
constexpr int N_PHASES = 13;
#ifndef REP_INIT
#define REP_INIT {1,1,1,1,1,1,1,1,1,1,1,1,1}
#endif
__device__ constexpr int kRep[N_PHASES] = REP_INIT;
struct Args { const float* in[29]; float* out; unsigned char* ws; int ph_lo, ph_hi; };
static_assert(sizeof(Args) == 29 * 8 + 8 + 8 + 8, "Args has no padding");

template <class Epi>
__device__ __forceinline__ void run_gemm(const Ctx& F, const bf16* A, const bf16* Bt, int N, int K, const Epi& E) {
    int Kv = K; asm volatile("" : "+s"(Kv));
    pg8::Gemm g{A, Bt, MTOK, N, Kv}; pg8::StaticOrder S; S.init(MTOK, N, F.G, (int)blockIdx.x, N > 1024 ? GEMM_WGM_WIDE : GEMM_WGM_NARROW);
    pg8::gemm_phase<Epi, pg8::StaticOrder, true, true>(F.lds + RING_OFF, g, S, E);
}

__global__ void __launch_bounds__(NWAVES * 64, 2) mk_fwd(Args args) {
    extern __shared__ __attribute__((aligned(16))) unsigned char lds[];
    Ctx F;
    F.lds = (LAS unsigned char*)lds;
    F.tid = threadIdx.x; F.lane = F.tid & 63; F.wave = __builtin_amdgcn_readfirstlane(F.tid >> 6);
    F.G = gridDim.x; { const int bx = blockIdx.x; F.vcu = (F.G % 8 == 0) ? (bx % 8) * (F.G / 8) + bx / 8 : bx; }
    F.in = args.in;
    F.out = args.out; F.ws = args.ws;
    unsigned char* ws = args.ws;
    for (int u = F.tid; u < (LDS_BYTES - LDSCTL_OFF) / 4; u += NWAVES * 64) ((LAS unsigned*)(F.lds + LDSCTL_OFF))[u] = 0u;
    __syncthreads();
    const int lo = args.ph_lo, hi = args.ph_hi;
    const bool multi = (hi - lo) > 1;
    XcdBarrier bar; bar.bar = (unsigned*)(ws + WS_CTL) + CW_BAR; bar.x = 0; bar.st = nullptr;
    if (multi) bar = xcd_barrier_post((unsigned*)(ws + WS_CTL) + CW_BAR, (volatile LAS unsigned*)(F.lds + MISC_OFF) + 8);
#ifndef PHASE_MASK
#define PHASE_MASK 0x1fff
#endif
#define IN(k) (((PHASE_MASK >> (k)) & 1) && lo <= (k) && (k) < hi)
#define SEAM(k) do { if (IN(k) && IN((k) + 1)) xcd_barrier(bar); } while (0)
    float* ssq = (float*)(ws + WS_SSQ);
    bf16* XB = (bf16*)(ws + WS_XB);

    int pk = 0;
#define PHASE_BEGIN if (IN(pk)) for (int rep_ = 0; rep_ < kRep[pk]; ++rep_) { Ctx Fp = F; LAS unsigned char* eb = F.lds + EPI_LDS_OFF + F.wave * EPI_LDS_WAVE; (void)eb; asm volatile("" : "+v"(Fp.tid), "+v"(Fp.lane));
#define PHASE_END } SEAM(pk); ++pk;
    PHASE_BEGIN p0_prologue(Fp); PHASE_END
    PHASE_BEGIN EpiScaleBf16 E{(bf16*)(ws + WS_R1), IN0, ssq, eb}; run_gemm(Fp, XB, (const bf16*)(ws + WS_W_IN0T), IN0, 1024, E); PHASE_END
    PHASE_BEGIN if (rep_ > 0) __syncthreads(); p2_token_local(Fp); __syncthreads(); { Ctx Fq = F; asm volatile("" : "+v"(Fq.tid), "+v"(Fq.lane)); rwkv_chunk_prep(Fq); } PHASE_END
    PHASE_BEGIN rwkv_chunk_seq(Fp, Fp.vcu >> 1, Fp.vcu & 1, (Fp.vcu & 1) ? -1 : (Fp.vcu >> 1)); PHASE_END
    PHASE_BEGIN p5_postscan(Fp); PHASE_END
    PHASE_BEGIN EpiResid<false> E{Fp.in[I_X], (bf16*)(ws + WS_R2), ssq, eb}; run_gemm(Fp, XB, (const bf16*)(ws + WS_W_OUT0T), 1024, 1024, E); PHASE_END
    PHASE_BEGIN EpiSwiglu E{(bf16*)(ws + WS_R1), ssq, eb}; run_gemm(Fp, (const bf16*)(ws + WS_R2), (const bf16*)(ws + WS_W_GU0T), 2 * FFH, 1024, E); PHASE_END
    PHASE_BEGIN EpiResid<true> E{(const bf16*)(ws + WS_R2), XB, ssq, eb}; run_gemm(Fp, (const bf16*)(ws + WS_R1), (const bf16*)(ws + WS_W_DN0T), 1024, FFH, E); PHASE_END
    PHASE_BEGIN EpiProj1 E{ssq, (const float*)(ws + WS_ROPE), (const float*)(ws + WS_ROPE) + SEQ * 32, (bf16*)(ws + WS_Q), (bf16*)(ws + WS_KR), (bf16*)(ws + WS_VT), (bf16*)(ws + WS_IQ), (bf16*)(ws + WS_IK), (float*)(ws + WS_IW), eb};
                run_gemm(Fp, XB, (const bf16*)(ws + WS_W_IN1T), IN1P, 1024, E); PHASE_END
    PHASE_BEGIN dsa_phase(Fp); PHASE_END
    PHASE_BEGIN EpiResid<true> E{XB, XB, ssq, eb}; run_gemm(Fp, (const bf16*)(ws + WS_R1), (const bf16*)(ws + WS_W_OUT1T), 1024, 1024, E); PHASE_END
    PHASE_BEGIN EpiSwiglu E{(bf16*)(ws + WS_R2), ssq, eb}; run_gemm(Fp, XB, (const bf16*)(ws + WS_W_GU1T), 2 * FFH, 1024, E); PHASE_END
    PHASE_BEGIN EpiResidFinal E{XB, Fp.out, Fp.in[I_NORM_FINAL], (float*)(ws + WS_XCHG), (unsigned*)(ws + WS_CTL) + CW_PANEL, eb}; run_gemm(Fp, (const bf16*)(ws + WS_R2), (const bf16*)(ws + WS_W_DN1T), 1024, FFH, E); PHASE_END
#undef PHASE_BEGIN
#undef PHASE_END
#undef IN
#undef SEAM
}

extern "C" void kernel_launch(void* const* d_in, const int* in_sizes, int n_in, void* d_out, int out_size, void* d_ws, size_t ws_size, hipStream_t stream) {
    static int grid = 0;
    if (grid == 0) {
        if (n_in != 29 || in_sizes[0] != MTOK * DM || out_size != MTOK * DM || ws_size < WS_END2) {
            fprintf(stderr, "kernel_launch: unexpected shapes (n_in %d, in0 %d, out %d, ws %zu); nothing launched\n", n_in, n_in > 0 ? in_sizes[0] : -1, out_size, ws_size); grid = -1; return; }
        int dev = 0, cus = 0;
        if (hipGetDevice(&dev) != hipSuccess || hipDeviceGetAttribute(&cus, hipDeviceAttributeMultiprocessorCount, dev) != hipSuccess) { grid = -1; return; }
        if (hipFuncSetAttribute((const void*)mk_fwd, hipFuncAttributeMaxDynamicSharedMemorySize, LDS_BYTES) != hipSuccess) { fprintf(stderr, "kernel_launch: hipFuncSetAttribute failed\n"); grid = -1; return; }
        int per_cu = 0;
        if (hipOccupancyMaxActiveBlocksPerMultiprocessor(&per_cu, (const void*)mk_fwd, NWAVES * 64, LDS_BYTES) != hipSuccess || per_cu < 1)
            fprintf(stderr, "kernel_launch: note: occupancy query reports %d workgroups per CU\n", per_cu);
        (void)hipGetLastError();
        grid = cus;
        if (grid != 256) { fprintf(stderr, "kernel_launch: this kernel needs a 256-CU device (got %d)\n", grid); grid = -1; return; }
    }
    if (grid < 0) return;
    if (hipMemsetAsync((char*)d_ws + WS_CTL, 0, CTL_ZERO_BYTES, stream) != hipSuccess) { fprintf(stderr, "kernel_launch: memset failed\n"); return; }
    Args a{};
    for (int i = 0; i < 29; ++i) a.in[i] = (const float*)d_in[i];
    a.out = (float*)d_out; a.ws = (unsigned char*)d_ws;
#if MK_SINGLE
    a.ph_lo = 0; a.ph_hi = N_PHASES;
    hipLaunchKernelGGL(mk_fwd, dim3(grid), dim3(NWAVES * 64), LDS_BYTES, stream, a);
#else
    for (int p = 0; p < N_PHASES; ++p) { a.ph_lo = p; a.ph_hi = p + 1; hipLaunchKernelGGL(mk_fwd, dim3(grid), dim3(NWAVES * 64), LDS_BYTES, stream, a); }
#endif
}
```

```cpp
#include <hip/hip_runtime.h>
#include <cstdio>
#include <cstdint>
namespace pg8 {
#define PG8_LAS __attribute__((address_space(3)))
typedef unsigned short bf16_t;
typedef short bf16x8 __attribute__((ext_vector_type(8)));
typedef float f32x4 __attribute__((ext_vector_type(4)));
typedef unsigned u32x4 __attribute__((ext_vector_type(4)));
constexpr int BM = 256, BK = 64, HALF = 128, HTB = HALF * BK * 2  , STAGE_BYTES = 8 * HTB, NXCD = 8;

__host__ __device__ __forceinline__ int lds_byte(int r, int c) { const int st = (r >> 4) * 2 + (c >> 5), rr = r & 15, cc = c & 31, ob = rr * 64 + cc * 2; return st * 1024 + (ob ^ (((ob >> 9) & 1) << 5)); }
__host__ __device__ __forceinline__ void stage_rc(int b, int& R, int& C) { const int st = b / 1024, sb = b % 1024, swz = sb ^ (((sb >> 9) & 1) << 5); R = (st >> 1) * 16 + swz / 64; C = (st & 1) * 32 + (swz % 64) / 2; }
__host__ __device__ __forceinline__ int perm32(int rho) { const int n = rho >> 4, i = rho & 15; return 8 * (i >> 2) + 4 * n + (i & 3); }

struct Unit { int pm, pn; };
struct Gemm { const bf16_t* A; const bf16_t* Bt; int M, N, K; };

struct StaticOrder {
    int nM, nN, nwg, G, c, WGM;
    __host__ __device__ void init(int M, int N, int G_, int c_, int wgm) { nM = M / BM; nN = N / BM; nwg = nM * nN; G = G_; c = c_; WGM = wgm; }
    __host__ __device__ bool next(int i, Unit& u) const {
        const long L = (long)i * G + c; if (L >= nwg) return false;
        int wgid = (int)L; { const int q = nwg / NXCD, r = nwg % NXCD, xcd = wgid % NXCD, off = wgid / NXCD; wgid = (xcd < r ? xcd * (q + 1) : r * (q + 1) + (xcd - r) * q) + off; }
        const int nig = WGM * nN, gid = wgid / nig, fm = gid * WGM, gsz = (nM - fm) < WGM ? (nM - fm) : WGM;
        u.pm = fm + ((wgid % nig) % gsz); u.pn = (wgid % nig) / gsz; return true;
    }
    __device__ __forceinline__ void a_ready(const Unit&) const {}
    __device__ __forceinline__ void done(const Unit&) const {}
};
typedef __bf16 bf16x2_t __attribute__((ext_vector_type(2)));
typedef float f32x2_t __attribute__((ext_vector_type(2)));
__device__ __forceinline__ unsigned cvt_pk_bf16(float lo, float hi) { const f32x2_t v = {lo, hi}; return __builtin_bit_cast(unsigned, __builtin_convertvector(v, bf16x2_t)); }
template <bool PERM>
__device__ __forceinline__ void gemm_prestage_b(PG8_LAS unsigned char* lds, const Gemm g, const StaticOrder& S, const int tid) {
    const int wid = __builtin_amdgcn_readfirstlane(tid >> 6), K = g.K;
    Unit cur; if (!S.next(0, cur)) return;
    const size_t hstep = (size_t)HALF * K * 2;
    const char* cB = (const char*)g.Bt + (size_t)cur.pn * 2 * hstep;
#pragma unroll
    for (int h = 0; h < 2; ++h)
#pragma unroll
        for (int i = 0; i < 2; ++i) { int R, C; stage_rc(tid * 16 + i * 8192, R, C); const int Rb = PERM ? ((R & ~31) + perm32(R & 31)) : R;
            __builtin_amdgcn_global_load_lds((const unsigned*)(cB + h * hstep + (unsigned)(Rb * K + C) * 2u), (PG8_LAS unsigned*)(lds + (4 + h) * HTB + (unsigned)wid * 1024u + i * 8192), 16, 0, 0); }
}
template <class Epi, class Sched, bool ALIGN_EPI = false, bool SP2 = false>
__device__ __forceinline__ void gemm_phase(PG8_LAS unsigned char* lds, const Gemm g, const Sched& S, const Epi& E, const bool b_pre = false) {
    const int tid = threadIdx.x, wid = __builtin_amdgcn_readfirstlane(tid >> 6), lane = tid & 63, wr = wid >> 2, wc = wid & 3, fr = lane & 15, fq = lane >> 4;
    const int K = g.K, nt = K / BK;
    unsigned voffA[2], voffB[2];
#pragma unroll
    for (int i = 0; i < 2; ++i) { int R, C; stage_rc(tid * 16 + i * 8192, R, C); const int Rb = Epi::PERM ? ((R & ~31) + perm32(R & 31)) : R;
        voffA[i] = (unsigned)(R * K + C) * 2u; voffB[i] = (unsigned)(Rb * K + C) * 2u; }
    const size_t kstep = (size_t)(BK * 2);
    const size_t hstep = (size_t)HALF * K * 2;
    const size_t tstep = 2 * hstep;
    const unsigned ldsw = (unsigned)wid * 1024u;
    const int aoff = lds_byte(wr * 64 + fr, fq * 8), boff = lds_byte(wc * 32 + fr, fq * 8);
#define PG8_SA(b, h) (((b) * 2 + (h)) * HTB)
#define PG8_SB(b, h) ((4 + (b) * 2 + (h)) * HTB)
#define PG8_STAGE(bufoff, gbase, voff) do { _Pragma("unroll") for (int _i = 0; _i < 2; ++_i) \
        __builtin_amdgcn_global_load_lds((const unsigned*)((const char*)(gbase) + (voff)[_i]), (PG8_LAS unsigned*)(lds + (bufoff) + ldsw + _i * 8192), 16, 0, 0); } while (0)
#define PG8_LDA(dst, b, h) do { _Pragma("unroll") for (int m = 0; m < 4; ++m) _Pragma("unroll") for (int k = 0; k < 2; ++k) dst[m][k] = *(const PG8_LAS bf16x8*)(lds + PG8_SA(b, h) + aoff + m * 2048 + k * 1024); } while (0)
#define PG8_LDB(dst, b, h) do { _Pragma("unroll") for (int n = 0; n < 2; ++n) _Pragma("unroll") for (int k = 0; k < 2; ++k) dst[n][k] = *(const PG8_LAS bf16x8*)(lds + PG8_SB(b, h) + boff + n * 2048 + k * 1024); } while (0)
#define PG8_MMA(ai, bj, At, Bt) do { __builtin_amdgcn_s_setprio(1); _Pragma("unroll") for (int m = 0; m < 4; ++m) _Pragma("unroll") for (int n = 0; n < 2; ++n) _Pragma("unroll") for (int k = 0; k < 2; ++k) \
        acc[ai][bj][m][n] = __builtin_amdgcn_mfma_f32_16x16x32_bf16(Bt[n][k], At[m][k], acc[ai][bj][m][n], 0, 0, 0); __builtin_amdgcn_s_setprio(0); } while (0)
#define PG8_WAIT_V(n) asm volatile("s_waitcnt vmcnt(" #n ")" ::: "memory")
#define PG8_WAIT_L(n) asm volatile("s_waitcnt lgkmcnt(" #n ")" ::: "memory")
#define PG8_BAR __builtin_amdgcn_s_barrier()
#define PG8_SCHED __builtin_amdgcn_sched_barrier(0)
    Unit cur, nxt; int ui = 0;
    if (!S.next(0, cur)) return;
    f32x4 acc[2][2][4][2];
#pragma unroll
    for (int a = 0; a < 2; ++a)
#pragma unroll
        for (int b = 0; b < 2; ++b)
#pragma unroll
            for (int m = 0; m < 4; ++m)
#pragma unroll
                for (int n = 0; n < 2; ++n) acc[a][b][m][n] = (f32x4){0.f, 0.f, 0.f, 0.f};
    bf16x8 At[4][2], B0[2][2], B1[2][2];
    const char* cA = (const char*)g.A + (size_t)cur.pm * tstep; const char* cB = (const char*)g.Bt + (size_t)cur.pn * tstep;
    S.a_ready(cur);
    float rsc_[2][4];
    typename Epi::Pre p0_; if constexpr (Epi::CARRY) { int pfr = fr, pfq = fq; asm volatile("" : "+v"(pfr), "+v"(pfq)); E.pre(p0_, cur, wr, pfr, pfq); }
    if constexpr (SP2) {
        if (!b_pre) { PG8_STAGE(PG8_SB(0, 0), cB, voffB); PG8_STAGE(PG8_SB(0, 1), cB + hstep, voffB); }
        PG8_STAGE(PG8_SA(0, 0), cA, voffA); PG8_STAGE(PG8_SA(0, 1), cA + hstep, voffA);
        if (wr == 1) PG8_BAR;
        PG8_WAIT_V(2); PG8_BAR;
        PG8_STAGE(PG8_SB(1, 0), cB + kstep, voffB); PG8_STAGE(PG8_SA(1, 0), cA + kstep, voffA); PG8_STAGE(PG8_SB(1, 1), cB + hstep + kstep, voffB);
        PG8_WAIT_V(6); PG8_BAR;
    } else {
        PG8_STAGE(PG8_SB(0, 0), cB, voffB); PG8_STAGE(PG8_SA(0, 0), cA, voffA); PG8_STAGE(PG8_SB(0, 1), cB + hstep, voffB); PG8_STAGE(PG8_SA(0, 1), cA + hstep, voffA);
        if (wr == 1) PG8_BAR;
        PG8_WAIT_V(4); PG8_BAR;
        PG8_STAGE(PG8_SB(1, 0), cB + kstep, voffB); PG8_STAGE(PG8_SA(1, 0), cA + kstep, voffA); PG8_STAGE(PG8_SB(1, 1), cB + hstep + kstep, voffB);
        PG8_WAIT_V(6); PG8_BAR;
    }
    if constexpr (Epi::CARRY) { int pfr = fr; asm volatile("" : "+v"(pfr)); E.finish(p0_, pfr, rsc_); }
    for (;;) {
        const bool has_next = S.next(ui + 1, nxt);
        const char* nA = has_next ? (const char*)g.A + (size_t)nxt.pm * tstep : cA; const char* nB = has_next ? (const char*)g.Bt + (size_t)nxt.pn * tstep : cB;
        for (int t = 0; t < nt; t += 2) {
            const bool last = (t == nt - 2);
            const char* a1 = cA + (size_t)(t + 1) * kstep;
            const char* a2 = last ? nA : cA + (size_t)(t + 2) * kstep; const char* b2 = last ? nB : cB + (size_t)(t + 2) * kstep;
            const char* a3 = a2 + kstep; const char* b3 = b2 + kstep;
            if (last && has_next) S.a_ready(nxt);
            if constexpr (SP2) {
            PG8_LDB(B0, 0, 0); PG8_LDB(B1, 0, 1); PG8_SCHED; PG8_LDA(At, 0, 0); PG8_STAGE(PG8_SA(1, 1), a1 + hstep, voffA);
            PG8_WAIT_V(8); PG8_WAIT_L(0); PG8_BAR; PG8_MMA(0, 0, At, B0); PG8_MMA(0, 1, At, B1); PG8_BAR; PG8_SCHED;
            PG8_LDA(At, 0, 1); PG8_STAGE(PG8_SB(0, 0), b2, voffB); PG8_STAGE(PG8_SB(0, 1), b2 + hstep, voffB); PG8_STAGE(PG8_SA(0, 0), a2, voffA);
            PG8_WAIT_V(8); PG8_WAIT_L(0); PG8_BAR; PG8_MMA(1, 0, At, B0); PG8_MMA(1, 1, At, B1); PG8_BAR; PG8_SCHED;
            PG8_LDB(B0, 1, 0); PG8_LDB(B1, 1, 1); PG8_SCHED; PG8_LDA(At, 1, 0); PG8_STAGE(PG8_SA(0, 1), a2 + hstep, voffA);
            PG8_WAIT_V(8); PG8_WAIT_L(0); PG8_BAR; PG8_MMA(0, 0, At, B0); PG8_MMA(0, 1, At, B1); PG8_BAR; PG8_SCHED;
            PG8_LDA(At, 1, 1); PG8_STAGE(PG8_SB(1, 0), b3, voffB); PG8_STAGE(PG8_SB(1, 1), b3 + hstep, voffB); PG8_STAGE(PG8_SA(1, 0), a3, voffA);
            PG8_WAIT_V(8); PG8_WAIT_L(0); PG8_BAR; PG8_MMA(1, 0, At, B0); PG8_MMA(1, 1, At, B1); PG8_BAR; PG8_SCHED;
            } else {
            PG8_LDB(B0, 0, 0); PG8_SCHED; PG8_LDA(At, 0, 0); PG8_STAGE(PG8_SA(1, 1), a1 + hstep, voffA);
            PG8_WAIT_L(8); PG8_BAR; PG8_WAIT_L(0); PG8_MMA(0, 0, At, B0); PG8_BAR; PG8_SCHED;
            PG8_LDB(B1, 0, 1); PG8_STAGE(PG8_SB(0, 0), b2, voffB);
            PG8_BAR; PG8_WAIT_L(0); PG8_MMA(0, 1, At, B1); PG8_BAR;
            PG8_LDA(At, 0, 1); PG8_STAGE(PG8_SA(0, 0), a2, voffA);
            PG8_BAR; PG8_WAIT_L(0); PG8_MMA(1, 0, At, B0); PG8_BAR; PG8_SCHED;
            PG8_STAGE(PG8_SB(0, 1), b2 + hstep, voffB);
            PG8_WAIT_V(6); PG8_BAR; PG8_MMA(1, 1, At, B1); PG8_BAR;
            PG8_LDB(B0, 1, 0); PG8_SCHED; PG8_LDA(At, 1, 0); PG8_STAGE(PG8_SA(0, 1), a2 + hstep, voffA);
            PG8_WAIT_L(8); PG8_BAR; PG8_WAIT_L(0); PG8_MMA(0, 0, At, B0); PG8_BAR; PG8_SCHED;
            PG8_LDB(B1, 1, 1); PG8_STAGE(PG8_SB(1, 0), b3, voffB);
            PG8_BAR; PG8_WAIT_L(0); PG8_MMA(0, 1, At, B1); PG8_BAR;
            PG8_LDA(At, 1, 1); PG8_STAGE(PG8_SA(1, 0), a3, voffA);
            PG8_BAR; PG8_WAIT_L(0); PG8_MMA(1, 0, At, B0); PG8_BAR; PG8_SCHED;
            PG8_STAGE(PG8_SB(1, 1), b3 + hstep, voffB);
            PG8_WAIT_V(6); PG8_BAR; PG8_MMA(1, 1, At, B1); PG8_BAR;
            }
        }
        if constexpr (Epi::CARRY) {
            typename Epi::Pre pre_; { int pfr = fr, pfq = fq; asm volatile("" : "+v"(pfr), "+v"(pfq)); Unit un_ = cur; if (has_next) un_ = nxt; E.pre(pre_, un_, wr, pfr, pfq); }
            if constexpr (ALIGN_EPI) { if (wr == 0) PG8_BAR; }
            int efr = fr, efq = fq; asm volatile("" : "+v"(efr), "+v"(efq));
            E(acc, cur, wr, wc, efr, efq, rsc_); S.done(cur);
            E.finish(pre_, efr, rsc_);
        } else {
        typename Epi::Pre pre_; { int pfr = fr, pfq = fq; asm volatile("" : "+v"(pfr), "+v"(pfq)); E.pre(pre_, cur, wr, pfr, pfq); }
        if constexpr (ALIGN_EPI) { if (wr == 0) PG8_BAR; }
        if constexpr (!Epi::AFTER_DRAIN) { int efr = fr, efq = fq; asm volatile("" : "+v"(efr), "+v"(efq));
            E(acc, cur, wr, wc, efr, efq, pre_); S.done(cur); }
        }
        if (!has_next) break;
#pragma unroll
        for (int a = 0; a < 2; ++a)
#pragma unroll
            for (int b = 0; b < 2; ++b)
#pragma unroll
                for (int m = 0; m < 4; ++m)
#pragma unroll
                    for (int n = 0; n < 2; ++n) acc[a][b][m][n] = (f32x4){0.f, 0.f, 0.f, 0.f};
        cur = nxt; cA = nA; cB = nB; ++ui;
        if constexpr (ALIGN_EPI) { if (wr == 1) PG8_BAR; }
    }
    PG8_WAIT_V(0);
    if constexpr (!ALIGN_EPI) { if (wr == 0) PG8_BAR; }
    PG8_BAR;
    if constexpr (Epi::AFTER_DRAIN) { E.fused(acc, cur, wr, wc, fr, fq, lds, wid, lane); S.done(cur); }
#undef PG8_SA
#undef PG8_SB
#undef PG8_STAGE
#undef PG8_LDA
#undef PG8_LDB
#undef PG8_MMA
#undef PG8_WAIT_V
#undef PG8_WAIT_L
#undef PG8_BAR
#undef PG8_SCHED
}
}
#define GAS __attribute__((address_space(1)))
#define LAS __attribute__((address_space(3)))
typedef unsigned short bf16;
typedef unsigned v4u __attribute__((ext_vector_type(4)));
typedef float f32x4 __attribute__((ext_vector_type(4)));
typedef short bf16x8 __attribute__((ext_vector_type(8)));
typedef GAS unsigned gu32;
typedef GAS unsigned long long gu64;
#define RLX_AGENT __ATOMIC_RELAXED, __HIP_MEMORY_SCOPE_AGENT
#define LDS_WAIT() asm volatile("s_waitcnt lgkmcnt(0)" ::: "memory")
#define VM_WAIT() asm volatile("s_waitcnt vmcnt(0)" ::: "memory")
__device__ __forceinline__ unsigned long long rt() { return __builtin_amdgcn_s_memrealtime(); }
__device__ __forceinline__ unsigned f2bf(float f) { unsigned u = __builtin_bit_cast(unsigned, f); return (u + 0x7fffu + ((u >> 16) & 1u)) >> 16; }
__device__ __forceinline__ unsigned pk2(float lo, float hi) { return f2bf(lo) | (f2bf(hi) << 16); }

#define XB_TMO      128
#define XB_XCNT(j)  (256  + 64 * (j))
#define XB_XSUB(j)  (1280 + 64 * (j))
#define XB_XGEN(j)  (2304 + 64 * (j))
#define XB_TOP      3328
#define XB_TOPGEN   3392
#define XCD_BAR_WORDS 3456
#define XB_SPIN_CAP (1u << 18)

__device__ __forceinline__ unsigned xb_ld(unsigned* p)              { return __hip_atomic_load(p, __ATOMIC_RELAXED, __HIP_MEMORY_SCOPE_AGENT); }
__device__ __forceinline__ unsigned xb_add(unsigned* p, unsigned v) { return __hip_atomic_fetch_add(p, v, __ATOMIC_RELAXED, __HIP_MEMORY_SCOPE_AGENT); }
__device__ __forceinline__ unsigned xb_xcc_id() { return (unsigned)__builtin_amdgcn_s_getreg((3 << 11) | 20) & 0xFu; }
#define XB_SPIN(cond, bar) do { unsigned _sp = 0; while (cond) { __builtin_amdgcn_s_sleep(1); \
    if ((++_sp & 255u) == 0u) { if (xb_ld(&(bar)[XB_TMO])) break; if (_sp > XB_SPIN_CAP) { atomicAdd(&(bar)[XB_TMO], 1u); break; } } } } while (0)

struct XcdBarrier {
    unsigned* bar; unsigned x;
    volatile LAS unsigned* st;
};

__device__ __forceinline__ XcdBarrier xcd_barrier_post(unsigned* bar, volatile LAS unsigned* st) {
    XcdBarrier b; b.bar = bar; b.x = xb_xcc_id(); b.st = st;
    if (threadIdx.x == 0) (void)xb_add(&bar[XB_XCNT(b.x)], 1u);
    return b;
}
__device__ __forceinline__ void xcd_barrier_complete(unsigned* bar, unsigned x, unsigned& nloc, unsigned& nx) {
    const unsigned G = gridDim.x * gridDim.y * gridDim.z;
    unsigned sum, cnt, mine, sp = 0u;
    for (;;) {
        sum = 0u; cnt = 0u; mine = 0u;
#pragma unroll
        for (unsigned j = 0; j < 16; ++j) { const unsigned c = xb_ld(&bar[XB_XCNT(j)]); sum += c; cnt += (c > 0u) ? 1u : 0u; mine = (j == x) ? c : mine; }
        if (sum == G) break;
        __builtin_amdgcn_s_sleep(1);
        if ((++sp & 255u) == 0u) { if (xb_ld(&bar[XB_TMO])) break; if (sp > XB_SPIN_CAP) { atomicAdd(&bar[XB_TMO], 1u); break; } }
    }
    nloc = mine > 0u ? mine : 1u; nx = cnt > 0u ? cnt : 1u;
}

struct XbNoPre { __device__ __forceinline__ void operator()() const {} };
template <class Pre = XbNoPre>
__device__ __forceinline__ void xcd_barrier(const XcdBarrier& b, const Pre& pre = Pre()) {
    asm volatile("s_waitcnt vmcnt(0)" ::: "memory");
    __syncthreads();
    pre();
    if (threadIdx.x == 0) {
        unsigned* bar = b.bar;
        __builtin_amdgcn_s_waitcnt(0);
        unsigned nloc = b.st[0], nx = b.st[1];
        if (nloc == 0u) { xcd_barrier_complete(bar, b.x, nloc, nx); b.st[0] = nloc; b.st[1] = nx; }
        const unsigned old = xb_add(&bar[XB_XSUB(b.x)], 1u);
        const unsigned gen = old / nloc;
        if (old + 1u == (gen + 1u) * nloc) {
            __builtin_amdgcn_fence(__ATOMIC_RELEASE, "agent");
            asm volatile("s_waitcnt vmcnt(0)" ::: "memory");
            const unsigned og = xb_add(&bar[XB_TOP], 1u);
            const unsigned tg = og / nx;
            if (og + 1u == (tg + 1u) * nx) xb_add(&bar[XB_TOPGEN], 1u);
            else XB_SPIN(xb_ld(&bar[XB_TOPGEN]) == tg, bar);
            __builtin_amdgcn_fence(__ATOMIC_ACQUIRE, "agent");
            xb_add(&bar[XB_XGEN(b.x)], 1u);
            asm volatile("s_waitcnt vmcnt(0)" ::: "memory");
        } else {
            XB_SPIN(xb_ld(&bar[XB_XGEN(b.x)]) == gen, bar);
            __builtin_amdgcn_fence(__ATOMIC_ACQUIRE, "agent");
            asm volatile("s_waitcnt vmcnt(0)" ::: "memory");
        }
    }
    __syncthreads();
}

constexpr int NWAVES = 8;
constexpr int BATCH = 16, SEQ = 2048, DM = 1024, MTOK = BATCH * SEQ;
constexpr int IN0 = 2816, FFH = 2816, IN1 = 1736, IN1P = 1792, RWKVW = 512, LRUW = 512;
constexpr float NORM_EPS = 1e-6f, GN_EPS = 64e-5f;
constexpr int C_R = 0, C_K = 512, C_V = 1024, C_WD = 1536, C_LX = 1792, C_LG = 2304;

constexpr size_t MiB = 1u << 20;
constexpr size_t WS_CTL = 0, CTL_ZERO_BYTES = 64 * 1024;
constexpr size_t WS_W_IN0T = 1 * MiB, WS_W_OUT0T = 7 * MiB, WS_W_GU0T = 9 * MiB, WS_W_DN0T = 20 * MiB, WS_W_IN1T = 26 * MiB, WS_W_OUT1T = 30 * MiB,
                 WS_W_GU1T = 32 * MiB, WS_W_DN1T = 43 * MiB, WS_W_LORAT = 49 * MiB, WS_W_GATET = 50 * MiB, WS_ROPE = 51 * MiB, WS_SSQ = 52 * MiB;
constexpr size_t WS_XB = 64 * MiB, WS_R1 = 128 * MiB, WS_R2 = 304 * MiB, WS_END = 480 * MiB;
constexpr size_t WS_DECAY = WS_R2, WS_LRUA = WS_R2 + 64 * MiB, WS_AARR = WS_R2 + 128 * MiB, WS_ALORA = WS_R2 + 160 * MiB;
constexpr size_t DO_G = 0, DO_LRUA1 = 64 * MiB, DO_LRUX = 96 * MiB;
constexpr size_t WS_Q = WS_R2, WS_IQ = WS_R2 + 64 * MiB, WS_KR = WS_R2 + 96 * MiB, WS_VT = WS_R2 + 100 * MiB, WS_IK = WS_R2 + 104 * MiB, WS_IW = WS_R2 + 108 * MiB;
constexpr size_t WS_BONUS = 58 * MiB;
constexpr size_t WS_LRUPS = 500 * MiB, WS_HIN = 508 * MiB;
constexpr int CW_BAR = 1024;

constexpr int RING_OFF = 0, RING_BYTES = 131072;
constexpr int LDSCTL_OFF = RING_BYTES, MISC_OFF = LDSCTL_OFF + 320;
constexpr int LDS_BYTES = 163840;
constexpr int EPI_LDS_OFF = 132096, EPI_LDS_WAVE = 3968;

typedef unsigned u32x2 __attribute__((ext_vector_type(2)));
typedef unsigned short u16x4 __attribute__((ext_vector_type(4)));
typedef unsigned short u16x8 __attribute__((ext_vector_type(8)));
typedef float f32x2 __attribute__((ext_vector_type(2)));

__device__ __forceinline__ float bf2f(unsigned b) { return __builtin_bit_cast(float, b << 16); }
__device__ __forceinline__ float bflo(unsigned w) { return __builtin_bit_cast(float, w << 16); }
__device__ __forceinline__ float bfhi(unsigned w) { return __builtin_bit_cast(float, w & 0xffff0000u); }
__device__ __forceinline__ unsigned pkbf(float lo, float hi) { return pg8::cvt_pk_bf16(lo, hi); }
__device__ __forceinline__ float sigmoidf_(float x) { return __builtin_amdgcn_rcpf(1.0f + __expf(-x)); }
__device__ __forceinline__ float softplusf_(float u) { return fmaxf(u, 0.f) + __logf(1.0f + __expf(-fabsf(u))); }
__device__ __forceinline__ float one_minus_exp(float x) { return x > -0.02f ? -x * (1.0f + x * (0.5f + x * (0.16666667f + x * 0.041666668f))) : 1.0f - __expf(x); }
__device__ __forceinline__ float tanhf_(float x) { const float e = __expf(-2.0f * fabsf(x)); const float t = (1.0f - e) * __builtin_amdgcn_rcpf(1.0f + e); return x < 0.f ? -t : t; }
__device__ __forceinline__ float gelu_tanh(float x) { const float u = 0.7978845608028654f * (x + 0.044715f * x * x * x); return 0.5f * x * (1.0f + tanhf_(u)); }
__device__ __forceinline__ float row_rstd(const float* ssq, int row) {
    const f32x4* p = (const f32x4*)(ssq + (size_t)row * 16);
    const f32x4 a = p[0], b = p[1], c = p[2], d = p[3];
    const float s = (((a[0] + a[1]) + (a[2] + a[3])) + ((b[0] + b[1]) + (b[2] + b[3]))) + (((c[0] + c[1]) + (c[2] + c[3])) + ((d[0] + d[1]) + (d[2] + d[3])));
    return rsqrtf(s * (1.0f / 1024.0f) + NORM_EPS);
}


template <int CTRL> __device__ __forceinline__ float dpp_mov(float x) { return __builtin_bit_cast(float, __builtin_amdgcn_update_dpp(0, __builtin_bit_cast(int, x), CTRL, 0xf, 0xf, true)); }
#define DPP_QP_1032 0xB1
#define DPP_QP_2301 0x4E
#define DPP_ROW_HALF_MIRROR 0x141
#define DPP_ROW_MIRROR 0x140
__device__ __forceinline__ float row8_sum(float x) {
    x += dpp_mov<DPP_QP_1032>(x); x += dpp_mov<DPP_QP_2301>(x); x += dpp_mov<DPP_ROW_HALF_MIRROR>(x); return x; }
template <int CTRL, int RM> __device__ __forceinline__ int dpp_src0(int x) { return __builtin_amdgcn_update_dpp(0, x, CTRL, RM, 0xf, false); }
__device__ __forceinline__ int wave_prefix_incl(int x) {
    x += dpp_src0<0x111, 0xf>(x); x += dpp_src0<0x112, 0xf>(x); x += dpp_src0<0x114, 0xf>(x); x += dpp_src0<0x118, 0xf>(x);
    x += dpp_src0<0x142, 0xa>(x); x += dpp_src0<0x143, 0xc>(x); return x; }
__device__ __forceinline__ float row16_sum(float x) {
    x = row8_sum(x); x += dpp_mov<DPP_ROW_MIRROR>(x); return x; }
__device__ __forceinline__ void rows_gather4(float x, float& r0, float& r1, float& r2, float& r3) {
    const unsigned xi = __builtin_bit_cast(unsigned, x);
    const auto s = __builtin_amdgcn_permlane16_swap(xi, xi, false, false);
    const auto t0 = __builtin_amdgcn_permlane32_swap((unsigned)s[0], (unsigned)s[0], false, false), t1 = __builtin_amdgcn_permlane32_swap((unsigned)s[1], (unsigned)s[1], false, false);
    r0 = __builtin_bit_cast(float, (unsigned)t0[0]); r2 = __builtin_bit_cast(float, (unsigned)t0[1]); r1 = __builtin_bit_cast(float, (unsigned)t1[0]); r3 = __builtin_bit_cast(float, (unsigned)t1[1]);
}

using pg8::Unit;
__device__ __forceinline__ v4u epi_to_rows(LAS unsigned char* s, const v4u v, int fr, int fq) { const int l = fq * 16 + fr;
    *(LAS v4u*)(s + fr * 80 + fq * 16) = v; return *(const LAS v4u*)(s + (l >> 2) * 80 + (l & 3) * 16); }
__device__ __forceinline__ v4u epi_from_rows(LAS unsigned char* s, const v4u v, int fr, int fq) { const int l = fq * 16 + fr;
    *(LAS v4u*)(s + (l >> 2) * 80 + (l & 3) * 16) = v; return *(const LAS v4u*)(s + fr * 80 + fq * 16); }
struct EpiPre { f32x4 p[2][4]; };
__device__ __forceinline__ void epi_rstd_load(const float* ssq, int rb0, int fr, int fq, EpiPre& P) { const int l = fq * 16 + fr;
#pragma unroll
    for (int ai = 0; ai < 2; ++ai)
#pragma unroll
        for (int m = 0; m < 4; ++m) P.p[ai][m] = *(const f32x4*)(ssq + (size_t)(rb0 + ai * 128 + m * 16 + (l >> 2)) * 16 + 4 * (l & 3));
}
__device__ __forceinline__ void epi_rstd_finish(const EpiPre& P, int fr, float (&rs)[2][4]) {
#pragma unroll
    for (int ai = 0; ai < 2; ++ai)
#pragma unroll
        for (int m = 0; m < 4; ++m) { const f32x4 p = P.p[ai][m];
            float s = (p[0] + p[1]) + (p[2] + p[3]); s += dpp_mov<DPP_QP_1032>(s); s += dpp_mov<DPP_QP_2301>(s);
            rs[ai][m] = __shfl(rsqrtf(s * (1.0f / 1024.0f) + NORM_EPS), 4 * fr); }
}
__device__ __forceinline__ void epi_rstd(const float* ssq, int rb0, int fr, int fq, float (&rs)[2][4]) { EpiPre P; epi_rstd_load(ssq, rb0, fr, fq, P); epi_rstd_finish(P, fr, rs); }
struct EpiScaleBf16 {
    typedef EpiPre Pre;
    static constexpr bool PERM = true, AFTER_DRAIN = false, CARRY = true;
    bf16* O; int ldc; const float* ssq; LAS unsigned char* eb;
    __device__ __forceinline__ void pre(EpiPre& P, const Unit& u, int wr, int fr, int fq) const { epi_rstd_load(ssq, u.pm * 256 + wr * 64, fr, fq, P); }
    __device__ __forceinline__ void finish(const EpiPre& P, int fr, float (&rs)[2][4]) const { epi_rstd_finish(P, fr, rs); }
    __device__ __forceinline__ void operator()(const f32x4 (&acc)[2][2][4][2], const Unit& u, int wr, int wc, int fr, int fq, const float (&rs)[2][4]) const {
        const int l = fq * 16 + fr, rb0 = u.pm * 256 + wr * 64, cw = u.pn * 256 + wc * 32;
#pragma unroll
        for (int ai = 0; ai < 2; ++ai)
#pragma unroll
            for (int m = 0; m < 4; ++m) { const float r = rs[ai][m]; bf16* rowp = O + (size_t)(rb0 + ai * 128 + m * 16 + (l >> 2)) * ldc + cw + 8 * (l & 3);
#pragma unroll
                for (int bj = 0; bj < 2; ++bj) { const f32x4 v0 = acc[ai][bj][m][0] * r, v1 = acc[ai][bj][m][1] * r;
                    v4u w; w.x = pkbf(v0[0], v0[1]); w.y = pkbf(v0[2], v0[3]); w.z = pkbf(v1[0], v1[1]); w.w = pkbf(v1[2], v1[3]);
                    *(v4u*)(rowp + bj * 128) = epi_to_rows(eb + ((m * 2 + bj) % 3) * 1280, w, fr, fq); } }
    }
};
struct EpiSwiglu {
    typedef EpiPre Pre;
    static constexpr bool PERM = true, AFTER_DRAIN = false, CARRY = true;
    bf16* O; const float* ssq; LAS unsigned char* eb;
    __device__ __forceinline__ void pre(EpiPre& P, const Unit& u, int wr, int fr, int fq) const { epi_rstd_load(ssq, u.pm * 256 + wr * 64, fr, fq, P); }
    __device__ __forceinline__ void finish(const EpiPre& P, int fr, float (&rs)[2][4]) const { epi_rstd_finish(P, fr, rs); }
    __device__ __forceinline__ void operator()(const f32x4 (&acc)[2][2][4][2], const Unit& u, int wr, int wc, int fr, int fq, const float (&rs)[2][4]) const {
        const int l = fq * 16 + fr, rb0 = u.pm * 256 + wr * 64, cw = u.pn * 128 + wc * 32;
#pragma unroll
        for (int ai = 0; ai < 2; ++ai)
#pragma unroll
            for (int m = 0; m < 4; ++m) { const float r = rs[ai][m], rn = r * -1.4426950408889634f, r2 = r * r;
                float a[8];
#pragma unroll
                for (int n = 0; n < 2; ++n) {
                    const f32x4 G = acc[ai][0][m][n], U = acc[ai][1][m][n]; const f32x4 X = G * rn, T = (G * U) * r2;
                    f32x4 S;
#pragma unroll
                    for (int e = 0; e < 4; ++e) S[e] = __builtin_amdgcn_rcpf(1.0f + __builtin_amdgcn_exp2f(X[e]));
                    const f32x4 A = T * S;
#pragma unroll
                    for (int e = 0; e < 4; ++e) a[n * 4 + e] = A[e]; }
                v4u w; w.x = pkbf(a[0], a[1]); w.y = pkbf(a[2], a[3]); w.z = pkbf(a[4], a[5]); w.w = pkbf(a[6], a[7]);
                *(v4u*)(O + (size_t)(rb0 + ai * 128 + m * 16 + (l >> 2)) * FFH + cw + 8 * (l & 3)) = epi_to_rows(eb + (m % 3) * 1280, w, fr, fq); }
    }
};
template <bool RESID_BF16> struct EpiResid {
    typedef EpiPre Pre;
    static constexpr bool PERM = true, AFTER_DRAIN = false, CARRY = false;
    const void* resid; bf16* xb; float* ssq; LAS unsigned char* eb;
    __device__ __forceinline__ void pre(EpiPre&, const Unit&, int, int, int) const {}
    __device__ __forceinline__ void operator()(const f32x4 (&acc)[2][2][4][2], const Unit& u, int wr, int wc, int fr, int fq, const EpiPre&) const {
        const int l = fq * 16 + fr, rb0 = u.pm * 256 + wr * 64, cw = u.pn * 256 + wc * 32;
        if constexpr (RESID_BF16) {
            v4u rv[2][4][2];
#pragma unroll
            for (int ai = 0; ai < 2; ++ai)
#pragma unroll
                for (int m = 0; m < 4; ++m)
#pragma unroll
                    for (int bj = 0; bj < 2; ++bj) rv[ai][m][bj] = *(const v4u*)((const bf16*)resid + (size_t)(rb0 + ai * 128 + m * 16 + (l >> 2)) * DM + cw + bj * 128 + 8 * (l & 3));
#pragma unroll
            for (int ai = 0; ai < 2; ++ai)
#pragma unroll
                for (int m = 0; m < 4; ++m) { const int rbase = rb0 + ai * 128 + m * 16; float ss = 0.f;
#pragma unroll
                    for (int bj = 0; bj < 2; ++bj) { const v4u rf = epi_from_rows(eb + bj * 1280, rv[ai][m][bj], fr, fq);
                        const f32x4 o0 = (f32x4){bflo(rf.x), bfhi(rf.x), bflo(rf.y), bfhi(rf.y)} + acc[ai][bj][m][0], o1 = (f32x4){bflo(rf.z), bfhi(rf.z), bflo(rf.w), bfhi(rf.w)} + acc[ai][bj][m][1];
                        ss += ((o0[0] * o0[0] + o0[1] * o0[1]) + (o0[2] * o0[2] + o0[3] * o0[3])) + ((o1[0] * o1[0] + o1[1] * o1[1]) + (o1[2] * o1[2] + o1[3] * o1[3]));
                        v4u w; w.x = pkbf(o0[0], o0[1]); w.y = pkbf(o0[2], o0[3]); w.z = pkbf(o1[0], o1[1]); w.w = pkbf(o1[2], o1[3]);
                        *(v4u*)(xb + (size_t)(rbase + (l >> 2)) * DM + cw + bj * 128 + 8 * (l & 3)) = epi_to_rows(eb + 2560, w, fr, fq); }
                    ss += __shfl_xor(ss, 16); ss += __shfl_xor(ss, 32);
                    if (fq == 0) ssq[(size_t)(rbase + fr) * 16 + u.pn * 4 + wc] = ss; }
        } else {
#pragma unroll
            for (int ai = 0; ai < 2; ++ai) {
                f32x4 rv[4][2][2];
#pragma unroll
                for (int m = 0; m < 4; ++m)
#pragma unroll
                    for (int bj = 0; bj < 2; ++bj)
#pragma unroll
                        for (int i = 0; i < 2; ++i) rv[m][bj][i] = *(const f32x4*)((const float*)resid + (size_t)(rb0 + ai * 128 + m * 16 + (l >> 3) + 8 * i) * DM + cw + bj * 128 + 4 * (l & 7));
#pragma unroll
                for (int m = 0; m < 4; ++m) { const int rbase = rb0 + ai * 128 + m * 16; float ss = 0.f;
#pragma unroll
                    for (int bj = 0; bj < 2; ++bj) {
#pragma unroll
                        for (int i = 0; i < 2; ++i) *(LAS f32x4*)(eb + ((l >> 3) + 8 * i) * 144 + (l & 7) * 16) = rv[m][bj][i];
                        const f32x4 o0 = *(const LAS f32x4*)(eb + fr * 144 + fq * 32) + acc[ai][bj][m][0], o1 = *(const LAS f32x4*)(eb + fr * 144 + fq * 32 + 16) + acc[ai][bj][m][1];
                        ss += ((o0[0] * o0[0] + o0[1] * o0[1]) + (o0[2] * o0[2] + o0[3] * o0[3])) + ((o1[0] * o1[0] + o1[1] * o1[1]) + (o1[2] * o1[2] + o1[3] * o1[3]));
                        v4u w; w.x = pkbf(o0[0], o0[1]); w.y = pkbf(o0[2], o0[3]); w.z = pkbf(o1[0], o1[1]); w.w = pkbf(o1[2], o1[3]);
                        *(v4u*)(xb + (size_t)(rbase + (l >> 2)) * DM + cw + bj * 128 + 8 * (l & 3)) = epi_to_rows(eb + 2560, w, fr, fq); }
                    ss += __shfl_xor(ss, 16); ss += __shfl_xor(ss, 32);
                    if (fq == 0) ssq[(size_t)(rbase + fr) * 16 + u.pn * 4 + wc] = ss; } }
        }
    }
};
constexpr size_t WS_XCHG = 56 * MiB;
constexpr int CW_PANEL = 8192;
struct EpiResidFinal {
    typedef EpiPre Pre;
    static constexpr bool PERM = true, AFTER_DRAIN = false, CARRY = false;
    const bf16* resid; float* out; const float* gain; float* xchg; unsigned* cnt; LAS unsigned char* eb;
    __device__ __forceinline__ void pre(EpiPre&, const Unit&, int, int, int) const {}
    __device__ __forceinline__ void operator()(const f32x4 (&acc_)[2][2][4][2], const Unit& u, int wr, int wc, int fr, int fq, const EpiPre&) const {
        f32x4 (&acc)[2][2][4][2] = const_cast<f32x4 (&)[2][2][4][2]>(acc_);
        const int l = fq * 16 + fr, rb0 = u.pm * 256 + wr * 64, cw = u.pn * 256 + wc * 32;
        { v4u rv[2][4][2];
#pragma unroll
          for (int ai = 0; ai < 2; ++ai)
#pragma unroll
              for (int m = 0; m < 4; ++m)
#pragma unroll
                  for (int bj = 0; bj < 2; ++bj) rv[ai][m][bj] = *(const v4u*)(resid + (size_t)(rb0 + ai * 128 + m * 16 + (l >> 2)) * DM + cw + bj * 128 + 8 * (l & 3));
#pragma unroll
          for (int ai = 0; ai < 2; ++ai)
#pragma unroll
              for (int m = 0; m < 4; ++m) { const int row = rb0 + ai * 128 + m * 16 + fr; float ss = 0.f;
#pragma unroll
                  for (int bj = 0; bj < 2; ++bj) { const v4u rf = epi_from_rows(eb + ((m * 2 + bj) % 3) * 1280, rv[ai][m][bj], fr, fq);
                      const f32x4 o0 = (f32x4){bflo(rf.x), bfhi(rf.x), bflo(rf.y), bfhi(rf.y)} + acc[ai][bj][m][0], o1 = (f32x4){bflo(rf.z), bfhi(rf.z), bflo(rf.w), bfhi(rf.w)} + acc[ai][bj][m][1];
                      acc[ai][bj][m][0] = o0; acc[ai][bj][m][1] = o1;
                      ss += ((o0[0] * o0[0] + o0[1] * o0[1]) + (o0[2] * o0[2] + o0[3] * o0[3])) + ((o1[0] * o1[0] + o1[1] * o1[1]) + (o1[2] * o1[2] + o1[3] * o1[3])); }
                  ss += __shfl_xor(ss, 16); ss += __shfl_xor(ss, 32);
                  if (fq == 0) __hip_atomic_store(xchg + (size_t)row * 16 + u.pn * 4 + wc, ss, __ATOMIC_RELAXED, __HIP_MEMORY_SCOPE_AGENT);
                  asm volatile("" ::: "memory"); } }
        asm volatile("s_waitcnt vmcnt(0)" ::: "memory");
        unsigned* c = cnt + 64 * u.pm;
        if ((threadIdx.x & 63) == 0) __hip_atomic_fetch_add(c, 1u, __ATOMIC_RELAXED, __HIP_MEMORY_SCOPE_AGENT);
        { unsigned spins = 0;
          while ((unsigned)__builtin_amdgcn_readfirstlane(__hip_atomic_load(c, __ATOMIC_RELAXED, __HIP_MEMORY_SCOPE_AGENT)) < 32u) { __builtin_amdgcn_s_sleep(2); if (++spins > (1u << 22)) break; } }
        __builtin_amdgcn_fence(__ATOMIC_ACQUIRE, "agent");
        asm volatile("s_waitcnt vmcnt(0)" ::: "memory");
        float rs[2][4]; epi_rstd(xchg, rb0, fr, fq, rs);
        const f32x4 g0 = *(const f32x4*)(gain + cw + 4 * (l & 7)), g1 = *(const f32x4*)(gain + cw + 128 + 4 * (l & 7));
#pragma unroll
        for (int ai = 0; ai < 2; ++ai)
#pragma unroll
            for (int m = 0; m < 4; ++m) { const int rbase = rb0 + ai * 128 + m * 16; const float r = rs[ai][m];
#pragma unroll
                for (int bj = 0; bj < 2; ++bj) {
                    *(LAS f32x4*)(eb + fr * 144 + fq * 32) = acc[ai][bj][m][0] * r; *(LAS f32x4*)(eb + fr * 144 + fq * 32 + 16) = acc[ai][bj][m][1] * r;
#pragma unroll
                    for (int i = 0; i < 2; ++i) { const f32x4 v = *(const LAS f32x4*)(eb + ((l >> 3) + 8 * i) * 144 + (l & 7) * 16);
                        *(f32x4*)(out + (size_t)(rbase + (l >> 3) + 8 * i) * DM + cw + bj * 128 + 4 * (l & 7)) = v * (bj ? g1 : g0); } }
                asm volatile("" ::: "memory"); }
    }
};
struct EpiProj1 {
    struct Pre : EpiPre { v4u tab[2][4]; };
    static constexpr bool PERM = false, AFTER_DRAIN = false, CARRY = false;
    const float* ssq; const unsigned char* rope; bf16 *Q, *KR, *VT, *IQ, *IK; float* IW; LAS unsigned char* eb;
    template <int BJ> __device__ __forceinline__ void half(const f32x4 (&acc)[2][2][4][2], const Unit& u, int wr, int wc, int fr, int fq, const float (&rs)[2][4], const v4u (&tab)[2][4]) const {
        const int l = fq * 16 + fr, rb0 = u.pm * 256 + wr * 64;
        const int pc = u.pn * 256 + BJ * 128 + wc * 32, gi = pc >> 6, w = (pc >> 5) & 1;
        const bool rope = (gi <= 16) || (gi >= 18 && gi <= 26);
        const unsigned rvo = (unsigned)((l >> 2) * 128 + (l & 3) * 16);
        if (rope) {
#pragma unroll
            for (int ai = 0; ai < 2; ++ai) {
#pragma unroll
                for (int m = 0; m < 4; ++m) { const int rbase = rb0 + ai * 128 + m * 16; const float r = rs[ai][m];
                    const f32x4 x0 = acc[ai][BJ][m][0] * r, x1 = acc[ai][BJ][m][1] * r;
                    typedef _Float16 f16x4 __attribute__((ext_vector_type(4)));
                    u32x2 tc, ts; tc.x = tab[ai][m].x; tc.y = tab[ai][m].y; ts.x = tab[ai][m].z; ts.y = tab[ai][m].w;
                    const f32x4 cs = __builtin_convertvector(__builtin_bit_cast(f16x4, tc), f32x4), sn = __builtin_convertvector(__builtin_bit_cast(f16x4, ts), f32x4);
                    f32x4 o1 = x0 * cs - x1 * sn, o2 = x0 * sn + x1 * cs;
                    if (gi <= 16) {
                        if (gi < 16) { o1 = o1 * 0.18033688011112042f; o2 = o2 * 0.18033688011112042f; }
                        u32x2 w1, w2; w1.x = pkbf(o1[0], o1[1]); w1.y = pkbf(o1[2], o1[3]); w2.x = pkbf(o2[0], o2[1]); w2.y = pkbf(o2[2], o2[3]);
                        *(LAS u32x2*)(eb + 2560 + fr * 80 + fq * 8) = w1; *(LAS u32x2*)(eb + 2560 + fr * 80 + 32 + fq * 8) = w2;
                        const v4u rd = *(const LAS v4u*)(eb + 2560 + (l >> 2) * 80 + ((l >> 1) & 1) * 32 + (l & 1) * 16);
                        const int dd = ((l >> 1) & 1) * 32 + (l & 1) * 8;
                        if (gi < 16) *(v4u*)((char*)(Q + (size_t)rbase * 1024 + gi * 64 + 16 * w) + (unsigned)(((l >> 2) * 1024 + dd) * 2)) = rd;
                        else *(v4u*)((char*)(KR + (size_t)rbase * 64 + 16 * w) + (unsigned)(((l >> 2) * 64 + dd) * 2)) = rd;
                    } else {
                        if (gi < 26) { o1 = o1 * 0.125f; o2 = o2 * 0.125f; }
                        const unsigned a0 = pkbf(o1[0], o1[1]), a1 = pkbf(o1[2], o1[3]), b0 = pkbf(o2[0], o2[1]), b1 = pkbf(o2[2], o2[3]);
                        const auto s0 = __builtin_amdgcn_permlane16_swap(a0, b0, false, false), s1 = __builtin_amdgcn_permlane16_swap(a1, b1, false, false);
                        v4u st; st.x = (unsigned)s0[0]; st.y = (unsigned)s1[0]; st.z = (unsigned)s0[1]; st.w = (unsigned)s1[1];
                        const int gsl = (fq >> 1) * 16;
                        if (gi < 26) *(v4u*)((char*)(IQ + (size_t)(rbase >> 1) * 1024 + (2 * w * 16 + (gi - 18)) * 8) + (unsigned)(((fr >> 1) * 1024 + (fq & 1) * 512 + (gsl + (fr & 1) * 8) * 8) * 2)) = st;
                        else *(v4u*)((char*)(IK + (size_t)(rbase >> 4) * 1024 + 2 * w * 16 * 8) + (unsigned)(((fq & 1) * 512 + (gsl + fr) * 8) * 2)) = st; } } }
        } else if (gi == 17) {
#pragma unroll
            for (int ai = 0; ai < 2; ++ai)
#pragma unroll
                for (int m = 0; m < 4; ++m) { const int rbase = rb0 + ai * 128 + m * 16; const float r = rs[ai][m];
                    const f32x4 x0 = acc[ai][BJ][m][0] * r, x1 = acc[ai][BJ][m][1] * r;
                    u32x2 w1, w2; w1.x = pkbf(x0[0], x0[1]); w1.y = pkbf(x0[2], x0[3]); w2.x = pkbf(x1[0], x1[1]); w2.y = pkbf(x1[2], x1[3]);
                    LAS unsigned char* sl = eb + (m % 3) * 1280;
                    *(LAS u32x2*)(sl + fr * 80 + fq * 8) = w1; *(LAS u32x2*)(sl + fr * 80 + 32 + fq * 8) = w2;
                    *(v4u*)((char*)(VT + (size_t)rbase * 64 + 32 * w) + rvo) = *(const LAS v4u*)(sl + (l >> 2) * 80 + (l & 3) * 16); }
        } else if (gi == 27) {
#pragma unroll
            for (int ai = 0; ai < 2; ++ai)
#pragma unroll
                for (int m = 0; m < 4; ++m) { const int row = rb0 + ai * 128 + m * 16 + fr; if (w == 0 && fq < 2) *(f32x4*)(IW + (size_t)row * 8 + 4 * fq) = acc[ai][BJ][m][0] * (rs[ai][m] * 0.35355339059327373f); }
        }
    }
    __device__ __forceinline__ void pre(Pre& P, const Unit& u, int wr, int fr, int fq) const { epi_rstd_load(ssq, u.pm * 256 + wr * 64, fr, fq, P);
        const unsigned lo = (unsigned)((((int)threadIdx.x >> 6) & 1) * 1024 + (fq * 16 + fr) * 16);
#pragma unroll
        for (int ai = 0; ai < 2; ++ai)
#pragma unroll
            for (int m = 0; m < 4; ++m) { const int tb = (u.pm * 256 + wr * 64 + ai * 128 + m * 16) & (SEQ - 1);
                P.tab[ai][m] = *(const v4u*)(rope + (tb >> 4) * 2048 + lo); } }
    __device__ __forceinline__ void operator()(const f32x4 (&acc)[2][2][4][2], const Unit& u, int wr, int wc, int fr, int fq, const Pre& P) const {
        float rs[2][4]; epi_rstd_finish(P, fr, rs);
        half<0>(acc, u, wr, wc, fr, fq, rs, P.tab); half<1>(acc, u, wr, wc, fr, fq, rs, P.tab);
    }
};


struct Ctx {
    LAS unsigned char* lds;
    int tid, lane, wave, vcu, G;
    const float* const* in; float* out; unsigned char* ws;
};
enum { I_X = 0, I_NORM_MIX, I_W_IN0, I_MU, I_W_DECAY0, I_W_DECAY_UP, I_A_BIAS, I_W_A_UP, I_W_G_UP, I_K_K, I_K_A, I_R_K, I_LNX_W, I_LNX_B, I_CONV_W, I_CONV_B,
       I_W_RGATE, I_B_RGATE, I_W_IGATE, I_B_IGATE, I_LAMBDA, I_W_OUT0, I_W_IN1, I_W_OUT1, I_NORM_FFN, I_FFN_GATE, I_FFN_UP, I_FFN_DOWN, I_NORM_FINAL };

__device__ __forceinline__ float wave_sum(float v) {
#pragma unroll
    for (int o = 1; o < 64; o <<= 1) v += __shfl_xor(v, o);
    return v;
}

enum { MAP_ID = 0, MAP_GATE = 1, MAP_UP = 2, MAP_IN1 = 3 };
__device__ __forceinline__ int map_row(int mode, int n) {
    if (mode == MAP_GATE) return (n >> 7) * 256 + (n & 127);
    if (mode == MAP_UP) return (n >> 7) * 256 + 128 + (n & 127);
    if (mode == MAP_IN1) { const int gi = n >> 6, d = n & 63; const bool rope = (gi <= 16) || (gi >= 18 && gi <= 26);
        if (!rope) return n;
        const int ph = d < 32 ? ((d >> 4) * 32 + (d & 15)) : (((d - 32) >> 4) * 32 + 16 + ((d - 32) & 15));
        return gi * 64 + ph; }
    return n;
}
__device__ __forceinline__ void p0_transpose_item(const float* W, int K, int N, int Npad, const float* gain, bf16* WT, int mode, LAS float* scr, int item, int lane) {
    const int nblk = Npad >> 6, kb = item / nblk, nb = item - kb * nblk, k0 = 64 * kb, n0 = 64 * nb;
    const int nq = 4 * (lane & 7);
    f32x4 v[2][8];
#pragma unroll
    for (int h = 0; h < 2; ++h) { const int ncol = n0 + 32 * h + nq; const bool cin = ncol < N;
#pragma unroll
        for (int i = 0; i < 8; ++i) { const int kk = 8 * i + (lane >> 3); v[h][i] = (f32x4){0.f, 0.f, 0.f, 0.f};
            if (cin) v[h][i] = *(const f32x4*)(W + (size_t)(k0 + kk) * N + ncol); } }
#pragma unroll
    for (int h = 0; h < 2; ++h) {
#pragma unroll
        for (int i = 0; i < 8; ++i) { const int kk = 8 * i + (lane >> 3); f32x4 x = v[h][i];
            if (gain) x = x * gain[k0 + kk];
            scr[kk * 33 + nq] = x[0]; scr[kk * 33 + nq + 1] = x[1]; scr[kk * 33 + nq + 2] = x[2]; scr[kk * 33 + nq + 3] = x[3]; }
        LDS_WAIT(); asm volatile("" ::: "memory");
        const int c = lane & 7;
#pragma unroll
        for (int j = 0; j < 4; ++j) { const int n = (lane >> 3) + 8 * j; const LAS float* s = scr + (8 * c) * 33 + n;
            v4u o; o.x = pkbf(s[0 * 33], s[1 * 33]); o.y = pkbf(s[2 * 33], s[3 * 33]); o.z = pkbf(s[4 * 33], s[5 * 33]); o.w = pkbf(s[6 * 33], s[7 * 33]);
            *(v4u*)(WT + (size_t)map_row(mode, n0 + 32 * h + n) * K + k0 + 8 * c) = o; }
        LDS_WAIT(); asm volatile("" ::: "memory"); }
}
constexpr int P0_I_A = 16 * 44, P0_I_B = 16 * 16, P0_I_D = 44 * 16, P0_I_C = 16 * 28;
constexpr int P0_NITEMS = 7 * P0_I_A + 2 * P0_I_B + P0_I_C;
constexpr int P0_NITEMS_L0 = 4 * P0_I_A + P0_I_B;
static_assert(P0_I_A == P0_I_D, "item counts");
__device__ __forceinline__ void p0_weight_item_l0(const Ctx& F, LAS float* scr, int it) {
    constexpr int I_A = P0_I_A, I_B = P0_I_B; unsigned char* ws = F.ws;
    int r = it;
    if (r < I_A) { p0_transpose_item(F.in[I_W_IN0], 1024, IN0, IN0, F.in[I_NORM_MIX], (bf16*)(ws + WS_W_IN0T), MAP_ID, scr, r, F.lane); return; } r -= I_A;
    if (r < I_B) { p0_transpose_item(F.in[I_W_OUT0], 1024, 1024, 1024, nullptr, (bf16*)(ws + WS_W_OUT0T), MAP_ID, scr, r, F.lane); return; } r -= I_B;
    if (r < I_A) { p0_transpose_item(F.in[I_FFN_GATE], 1024, FFH, FFH, F.in[I_NORM_FFN], (bf16*)(ws + WS_W_GU0T), MAP_GATE, scr, r, F.lane); return; } r -= I_A;
    if (r < I_A) { p0_transpose_item(F.in[I_FFN_UP], 1024, FFH, FFH, F.in[I_NORM_FFN], (bf16*)(ws + WS_W_GU0T), MAP_UP, scr, r, F.lane); return; } r -= I_A;
    p0_transpose_item(F.in[I_FFN_DOWN], FFH, 1024, 1024, nullptr, (bf16*)(ws + WS_W_DN0T), MAP_ID, scr, r, F.lane);
}
__device__ __forceinline__ void p0_weight_item_l1(const Ctx& F, LAS float* scr, int it) {
    constexpr int I_A = P0_I_A, I_B = P0_I_B, I_C = P0_I_C; unsigned char* ws = F.ws;
    int r = it;
    if (r < I_C) { p0_transpose_item(F.in[I_W_IN1], 1024, IN1, IN1P, F.in[I_NORM_MIX] + 1024, (bf16*)(ws + WS_W_IN1T), MAP_IN1, scr, r, F.lane); return; } r -= I_C;
    if (r < I_B) { p0_transpose_item(F.in[I_W_OUT1], 1024, 1024, 1024, nullptr, (bf16*)(ws + WS_W_OUT1T), MAP_ID, scr, r, F.lane); return; } r -= I_B;
    if (r < I_A) { p0_transpose_item(F.in[I_FFN_GATE] + (size_t)1024 * FFH, 1024, FFH, FFH, F.in[I_NORM_FFN] + 1024, (bf16*)(ws + WS_W_GU1T), MAP_GATE, scr, r, F.lane); return; } r -= I_A;
    if (r < I_A) { p0_transpose_item(F.in[I_FFN_UP] + (size_t)1024 * FFH, 1024, FFH, FFH, F.in[I_NORM_FFN] + 1024, (bf16*)(ws + WS_W_GU1T), MAP_UP, scr, r, F.lane); return; } r -= I_A;
    p0_transpose_item(F.in[I_FFN_DOWN] + (size_t)FFH * 1024, FFH, 1024, 1024, nullptr, (bf16*)(ws + WS_W_DN1T), MAP_ID, scr, r, F.lane);
}
__device__ __forceinline__ void p0_layer1_weights(const Ctx& F, int widx, int nw) {
    LAS float* scr = (LAS float*)(F.lds + RING_OFF + F.wave * 16384);
    for (int it = widx; it < P0_NITEMS - P0_NITEMS_L0; it += nw) p0_weight_item_l1(F, scr, it);
}
__device__ __forceinline__ void p0_prologue(const Ctx& F) {
    LAS float* scr = (LAS float*)(F.lds + RING_OFF + F.wave * 16384);
    const int gw = F.vcu * NWAVES + F.wave, NGW = F.G * NWAVES;
    unsigned char* ws = F.ws;
    for (int it = gw; it < P0_NITEMS_L0; it += NGW) p0_weight_item_l0(F, scr, it);
    const int gt = F.vcu * (NWAVES * 64) + F.tid, NGT = F.G * NWAVES * 64;
    { bf16* L = (bf16*)(ws + WS_W_LORAT);
      for (int i = gt; i < 2 * 65536; i += NGT) { const int e = i & 7, ln = (i >> 3) & 63, gg = ln >> 4, cc = ln & 15; float v;
          if (i < 65536) { const int ks = (i >> 9) & 1, j = (i >> 10) & 3, h = (i >> 12) & 7, part = i >> 15; const int ch = 64 * h + 4 * cc + j, k = 32 * ks + 8 * gg + e;
              v = (part ? F.in[I_W_A_UP] : F.in[I_W_DECAY_UP])[k * 512 + ch]; }
          else { const int i2 = i - 65536, ks = (i2 >> 9) & 3, ct = (i2 >> 11) & 3, grp = i2 >> 13; const int n = 64 * grp + 16 * ct + cc, k = 32 * ks + 8 * gg + e;
              v = F.in[I_W_G_UP][k * 512 + n]; }
          L[i] = (bf16)(pkbf(v, 0.f) & 0xffffu); } }
    { bf16* Gt = (bf16*)(ws + WS_W_GATET);
      for (int i = gt; i < 65536; i += NGT) { const int e = i & 7, ln = (i >> 3) & 63, gg = ln >> 4, cc = ln & 15, ks = (i >> 9) & 1, ct = (i >> 10) & 3, gate = (i >> 12) & 1, h = i >> 13;
          const int jj = 16 * ct + cc, kk = 16 * (2 * ks + (e >> 2)) + 4 * gg + (e & 3);
          const float v = (gate ? F.in[I_W_IGATE] : F.in[I_W_RGATE])[h * 4096 + kk * 64 + jj];
          Gt[i] = (bf16)(pkbf(v, 0.f) & 0xffffu); } }
    { _Float16* rt = (_Float16*)(ws + WS_ROPE);
      for (int i = gt; i < SEQ * 32; i += NGT) { const int t = i >> 5, f = i & 31; const float invf = (float)pow(10000.0, -(double)f / 32.0); const float ang = (float)t * invf;
          const int o = (((t >> 4) * 2 + (f >> 4)) * 64 + ((f >> 2) & 3) * 16 + (t & 15)) * 8 + (f & 3);
          rt[o] = (_Float16)(float)cos((double)ang); rt[o + 4] = (_Float16)(float)sin((double)ang); } }
    { float* lsp = (float*)(ws + WS_ROPE + 512 * 1024); for (int i = gt; i < 512; i += NGT) lsp[i] = -8.0f * softplusf_(-F.in[I_LAMBDA][i]); }
    { bf16* XB = (bf16*)(ws + WS_XB); float* ssq = (float*)(ws + WS_SSQ); const float* x = F.in[I_X];
      f32x4 v[2][4], vn[2][4];
#pragma unroll
      for (int q = 0; q < 2; ++q) { const f32x4* xr = (const f32x4*)(x + (size_t)(gw + q * NGW) * DM) + F.lane;
#pragma unroll
          for (int j = 0; j < 4; ++j) v[q][j] = xr[64 * j]; }
      for (int m = gw; m < MTOK; m += 2 * NGW) { const int mn = (m + 2 * NGW < MTOK) ? m + 2 * NGW : m;
#pragma unroll
          for (int q = 0; q < 2; ++q) { const f32x4* xr = (const f32x4*)(x + (size_t)(mn + q * NGW) * DM) + F.lane;
#pragma unroll
              for (int j = 0; j < 4; ++j) vn[q][j] = xr[64 * j]; }
#pragma unroll
          for (int q = 0; q < 2; ++q) { const int mr = m + q * NGW; float s = 0.f;
#pragma unroll
              for (int j = 0; j < 4; ++j) s += (v[q][j][0] * v[q][j][0] + v[q][j][1] * v[q][j][1]) + (v[q][j][2] * v[q][j][2] + v[q][j][3] * v[q][j][3]);
              s = wave_sum(s);
              u32x2* o8 = (u32x2*)(XB + (size_t)mr * DM) + F.lane;
#pragma unroll
              for (int j = 0; j < 4; ++j) { u32x2 w; w.x = pkbf(v[q][j][0], v[q][j][1]); w.y = pkbf(v[q][j][2], v[q][j][3]); o8[64 * j] = w; }
              if (F.lane < 16) ssq[(size_t)mr * 16 + F.lane] = (F.lane == 0) ? s : 0.f; }
#pragma unroll
          for (int q = 0; q < 2; ++q)
#pragma unroll
              for (int j = 0; j < 4; ++j) v[q][j] = vn[q][j]; } }
}


__device__ __forceinline__ void unpack8(const v4u x, float (&o)[8]) { o[0] = bflo(x.x); o[1] = bfhi(x.x); o[2] = bflo(x.y); o[3] = bfhi(x.y); o[4] = bflo(x.z); o[5] = bfhi(x.z); o[6] = bflo(x.w); o[7] = bfhi(x.w); }
__device__ __forceinline__ float red8(float v) { return row8_sum(v); }
__device__ __forceinline__ void p5_postscan(const Ctx& F) {
    const int gw = F.vcu * NWAVES + F.wave, NGW = F.G * NWAVES, lane = F.lane, c0 = 8 * lane;
    const bf16* PROJ = (const bf16*)(F.ws + WS_R1); bf16* MIX = (bf16*)(F.ws + WS_XB);
    const bf16* Gg = (const bf16*)((const unsigned char*)F.out + DO_G); const float* BONUS = (const float*)(F.ws + WS_BONUS);
    float muv[8], lw[8], lb[8];
#pragma unroll
    for (int e = 0; e < 8; ++e) { muv[e] = F.in[I_MU][C_V + c0 + e]; lw[e] = F.in[I_LNX_W][c0 + e]; lb[e] = F.in[I_LNX_B][c0 + e]; }
    const v4u z4 = (v4u){0u, 0u, 0u, 0u};
    static_assert(MTOK == 256 * NWAVES * 16, "16 tokens per wave");
    const bf16* LRUC = (const bf16*)((const unsigned char*)F.out + DO_LRUA1); const bf16* LRUS = (const bf16*)((const unsigned char*)F.out + DO_LRUX);
    float hin[8];
    { const float* hp = (const float*)(F.ws + WS_HIN) + (size_t)gw * 512 + c0; const f32x4 h0 = *(const f32x4*)hp, h1 = *(const f32x4*)(hp + 4);
      hin[0] = h0[0]; hin[1] = h0[1]; hin[2] = h0[2]; hin[3] = h0[3]; hin[4] = h1[0]; hin[5] = h1[1]; hin[6] = h1[2]; hin[7] = h1[3]; }
    v4u vlast = z4;
    { const int m = gw * 16; if ((m & (SEQ - 1)) > 0) vlast = *(const v4u*)(PROJ + (size_t)(m - 1) * IN0 + c0 + C_V); }
    v4u yw[2][2], gw_[2][2], vc[2][2], hw[2][2], cw_[2][2], gt[2][2]; float bon[2][2];
#define POST_LOAD(S, K) do { _Pragma("unroll") for (int u = 0; u < 2; ++u) { const int m = gw * 16 + 2 * (K) + u; const bf16* p = PROJ + (size_t)m * IN0 + c0; \
            yw[S][u] = *(const v4u*)(MIX + (size_t)m * 1024 + c0); gw_[S][u] = *(const v4u*)(Gg + (size_t)m * 512 + c0); vc[S][u] = *(const v4u*)(p + C_V); \
            hw[S][u] = *(const v4u*)(LRUS + (size_t)m * 512 + c0); cw_[S][u] = *(const v4u*)(LRUC + (size_t)m * 512 + c0); gt[S][u] = *(const v4u*)(p + C_LG); \
            bon[S][u] = BONUS[(size_t)m * 8 + (lane >> 3)]; } } while (0)
    POST_LOAD(0, 0);
#pragma nounroll
    for (int k2 = 0; k2 < 8; k2 += 2)
#pragma unroll
    for (int S = 0; S < 2; ++S) { const int k = k2 + S;
        if (S == 0) POST_LOAD(1, k + 1); else POST_LOAD(0, (k + 1 < 8 ? k + 1 : 7));
        v4u vp[2]; vp[0] = vlast; vp[1] = vc[S][0]; vlast = vc[S][1];
#pragma unroll
        for (int u = 0; u < 2; ++u) { const int m = gw * 16 + 2 * k + u;
            float y[8], g[8], v[8], v1[8];
            unpack8(yw[S][u], y); unpack8(gw_[S][u], g); unpack8(vc[S][u], v); unpack8(vp[u], v1);
            float sy = 0.f; float vs[8];
#pragma unroll
            for (int e = 0; e < 8; ++e) { vs[e] = v[e] + (v1[e] - v[e]) * muv[e]; sy += y[e]; }
            sy = red8(sy);
            const float mean = sy * (1.0f / 64.0f); float sq = 0.f;
#pragma unroll
            for (int e = 0; e < 8; ++e) { const float d = y[e] - mean; sq += d * d; }
            sq = red8(sq);
            const float rstd = rsqrtf(sq * (1.0f / 64.0f) + GN_EPS); float o[8];
#pragma unroll
            for (int e = 0; e < 8; ++e) o[e] = ((y[e] - mean) * rstd * lw[e] + lb[e] + bon[S][u] * vs[e]) * g[e];
            v4u w; w.x = pkbf(o[0], o[1]); w.y = pkbf(o[2], o[3]); w.z = pkbf(o[4], o[5]); w.w = pkbf(o[6], o[7]);
            *(v4u*)(MIX + (size_t)m * 1024 + c0) = w;
            { float hh[8], cc8[8], gg[8], oo[8]; unpack8(hw[S][u], hh); unpack8(cw_[S][u], cc8); unpack8(gt[S][u], gg);
#pragma unroll
              for (int e = 0; e < 8; ++e) oo[e] = (cc8[e] * hin[e] + hh[e]) * gelu_tanh(gg[e]);
              v4u w2; w2.x = pkbf(oo[0], oo[1]); w2.y = pkbf(oo[2], oo[3]); w2.z = pkbf(oo[4], oo[5]); w2.w = pkbf(oo[6], oo[7]);
              *(v4u*)(MIX + (size_t)m * 1024 + 512 + c0) = w2; } } }
#undef POST_LOAD
}

__device__ __forceinline__ void p14_final(const Ctx& F) {
    const int gw = F.vcu * NWAVES + F.wave, NGW = F.G * NWAVES;
    f32x4 gn[4];
#pragma unroll
    for (int j = 0; j < 4; ++j) gn[j] = ((const f32x4*)F.in[I_NORM_FINAL])[F.lane + 64 * j];
    for (int m = gw; m < MTOK; m += NGW) { f32x4* xr = (f32x4*)(F.out + (size_t)m * DM) + F.lane; f32x4 v[4]; float s = 0.f;
#pragma unroll
        for (int j = 0; j < 4; ++j) { v[j] = xr[64 * j]; s += (v[j][0] * v[j][0] + v[j][1] * v[j][1]) + (v[j][2] * v[j][2] + v[j][3] * v[j][3]); }
        const float rs = rsqrtf(wave_sum(s) * (1.0f / 1024.0f) + NORM_EPS);
#pragma unroll
        for (int j = 0; j < 4; ++j) xr[64 * j] = v[j] * rs * gn[j]; }
}


__device__ __forceinline__ f32x4 mfma16_z(const bf16x8 a, const bf16x8 b) { f32x4 d; asm volatile("s_nop 1\n\tv_mfma_f32_16x16x32_bf16 %0, %1, %2, 0\n\ts_nop 9" : "=&v"(d) : "v"(a), "v"(b)); return d; }
__device__ __forceinline__ void mfma16_acc(f32x4& acc, const bf16x8 a, const bf16x8 b) { asm volatile("s_nop 1\n\tv_mfma_f32_16x16x32_bf16 %0, %1, %2, %0\n\ts_nop 9" : "+v"(acc) : "v"(a), "v"(b)); }
__device__ __forceinline__ f32x4 mfma4_z(const float a, const float b) { f32x4 d; asm volatile("s_nop 1\n\tv_mfma_f32_16x16x4_f32 %0, %1, %2, 0\n\ts_nop 13" : "=&v"(d) : "v"(a), "v"(b)); return d; }
typedef short s16x4 __attribute__((ext_vector_type(4)));
#ifndef DSA_RA
#define DSA_RA 1
#endif
#ifndef DSA_RB
#define DSA_RB 1
#endif
#ifndef DSA_RC
#define DSA_RC 1
#endif
#ifndef DSA_RAM
#define DSA_RAM 0
#endif
__device__ __forceinline__ void hist_pick(LAS unsigned* hist, int lane, int need, int& bin, int& above, int& cnt) {
    const v4u h4 = *(const LAS v4u*)(hist + 4 * lane);
    const int t = (int)(h4.x + h4.y + h4.z + h4.w);
    const int pin = wave_prefix_incl(t);
    const int tot = __builtin_amdgcn_readlane(pin, 63);
    const int excl = tot - pin, sfx = excl + t;
    const bool here = (excl < need) && (sfx >= need);
    int b = 0, ab = 0, cn = 0;
    { const int c3 = (int)h4.w, c2 = (int)h4.z, c1 = (int)h4.y, c0 = (int)h4.x;
      if (excl + c3 >= need) { b = 3; ab = excl; cn = c3; }
      else if (excl + c3 + c2 >= need) { b = 2; ab = excl + c3; cn = c2; }
      else if (excl + c3 + c2 + c1 >= need) { b = 1; ab = excl + c3 + c2; cn = c1; }
      else { b = 0; ab = excl + c3 + c2 + c1; cn = c0; } }
    const unsigned long long m = __ballot(here);
    const int src = m ? (__ffsll((long long)m) - 1) : 0;
    bin = __builtin_amdgcn_readlane(4 * lane + b, src); above = __builtin_amdgcn_readlane(ab, src); cnt = __builtin_amdgcn_readlane(cn, src);
}
__device__ __forceinline__ float relu_i(float x) { const int v = __builtin_bit_cast(int, x); return __builtin_bit_cast(float, v > 0 ? v : 0); }
__device__ __forceinline__ void dsa_phase(const Ctx& F) {
    const int lane = F.lane, wave = F.wave, kl = lane & 15, g = lane >> 4;
    LAS unsigned char* SC = F.lds;
    LAS unsigned char* mysc = SC + wave * 10240;
    LAS unsigned* hist = (LAS unsigned*)(F.lds + 81920 + wave * 1024);
    LAS unsigned* idxl = (LAS unsigned*)(F.lds + 90112 + wave * 2048);
    const bf16* Q = (const bf16*)(F.ws + WS_Q); const bf16* KR = (const bf16*)(F.ws + WS_KR); const bf16* Vm = (const bf16*)(F.ws + WS_VT);
    const bf16* IQ = (const bf16*)(F.ws + WS_IQ); const bf16* IK = (const bf16*)(F.ws + WS_IK); const float* IW = (const float*)(F.ws + WS_IW);
    bf16* ATT = (bf16*)(F.ws + WS_R1);
    const int b = F.vcu >> 4, sub = F.vcu & 15;
    const size_t rowb = (size_t)b * SEQ;
    bf16x8 aq0, aq1; f32x4 iw; bf16x8 ka[4][2], kb[4][2];
    const bf16* ikb = IK + (rowb >> 4) * 1024 + lane * 8;
#define DSA_A_PRE(J) do { const int grp_ = (((J) & 1) ? (15 - sub) : sub) + 16 * (J), qg_ = grp_ * 16, nt_ = (((grp_ >> 2) + 1) * 64) >> 4; \
        const bf16* iqp_ = IQ + (((rowb + qg_) >> 1) + wave) * 1024 + lane * 8; aq0 = *(const bf16x8*)iqp_; aq1 = *(const bf16x8*)(iqp_ + 512); \
        iw = *(const f32x4*)(IW + (rowb + qg_ + 2 * wave + (g >> 1)) * 8 + 4 * (g & 1)); \
        _Pragma("unroll") for (int u = 0; u < 4; ++u) { const bf16* ia_ = ikb + (size_t)min(u, nt_ - 1) * 1024; const bf16* ib_ = ikb + (size_t)min(4 + u, nt_ - 1) * 1024; \
            ka[u][0] = *(const bf16x8*)ia_; ka[u][1] = *(const bf16x8*)(ia_ + 512); kb[u][0] = *(const bf16x8*)ib_; kb[u][1] = *(const bf16x8*)(ib_ + 512); } } while (0)
    DSA_A_PRE(0);
    for (int j = 0; j < 8; ++j) {
        const int grp = ((j & 1) ? (15 - sub) : sub) + 16 * j;
        const int adm = ((grp >> 2) + 1) * 64;
        const int qg = grp * 16;
        for (int ra_ = 0; ra_ < DSA_RA; ++ra_) {
          const f32x2 w01 = (f32x2){iw[0], iw[1]}, w23 = (f32x2){iw[2], iw[3]};
          const int nt16 = adm >> 4;
          LAS unsigned char* dstb = mysc + (g >> 1) * 5120 + kl * 2;
#define DSA_IKLOAD(K, T0) do { _Pragma("unroll") for (int u = 0; u < 4; ++u) { const int tn = min((T0) + u, nt16 - 1); const bf16* ikp = ikb + (size_t)tn * 1024; K[u][0] = *(const bf16x8*)ikp; K[u][1] = *(const bf16x8*)(ikp + 512); } } while (0)
#define DSA_MM4(CC, K) asm volatile("s_nop 1\n\tv_mfma_f32_16x16x32_bf16 %0, %4, %6, 0\n\tv_mfma_f32_16x16x32_bf16 %1, %4, %8, 0\n\tv_mfma_f32_16x16x32_bf16 %2, %4, %10, 0\n\tv_mfma_f32_16x16x32_bf16 %3, %4, %12, 0\n\t" \
                         "v_mfma_f32_16x16x32_bf16 %0, %5, %7, %0\n\tv_mfma_f32_16x16x32_bf16 %1, %5, %9, %1\n\tv_mfma_f32_16x16x32_bf16 %2, %5, %11, %2\n\tv_mfma_f32_16x16x32_bf16 %3, %5, %13, %3\n\ts_nop 9" \
                         : "=&v"(CC[0]), "=&v"(CC[1]), "=&v"(CC[2]), "=&v"(CC[3]) \
                         : "v"(aq0), "v"(aq1), "v"(K[0][0]), "v"(K[0][1]), "v"(K[1][0]), "v"(K[1][1]), "v"(K[2][0]), "v"(K[2][1]), "v"(K[3][0]), "v"(K[3][1]))
#define DSA_EPI4(CC, T0) do { _Pragma("unroll") for (int u = 0; u < 4; ++u) { const int t = (T0) + u; \
                const f32x2 r01 = (f32x2){relu_i(CC[u][0]), relu_i(CC[u][1])}, r23 = (f32x2){relu_i(CC[u][2]), relu_i(CC[u][3])}; \
                const f32x2 s2 = r01 * w01 + r23 * w23; const float part = s2[0] + s2[1]; \
                const unsigned pu = __builtin_bit_cast(unsigned, part); \
                const auto sw = __builtin_amdgcn_permlane16_swap(pu, pu, false, false);     \
                float tot = __builtin_bit_cast(float, (unsigned)sw[0]) + __builtin_bit_cast(float, (unsigned)sw[1]); \
                tot = __builtin_amdgcn_fmed3f(tot, -60000.f, 60000.f); \
                const _Float16 hv = (_Float16)tot; \
                *(LAS unsigned short*)(dstb + (t >> 1) * 80 + (t & 1) * 32) = __builtin_bit_cast(unsigned short, hv); } } while (0)
          for (int t0 = 0; t0 < nt16; t0 += 8) {
              f32x4 ca[4], cb[4]; const bool two = t0 + 4 < nt16;
              DSA_MM4(ca, ka); DSA_IKLOAD(ka, t0 + 8); DSA_EPI4(ca, t0);
              if (two) DSA_MM4(cb, kb);
              DSA_IKLOAD(kb, t0 + 12);
              if (two) DSA_EPI4(cb, t0 + 4);
          }
#undef DSA_IKLOAD
#undef DSA_MM4
#undef DSA_EPI4
        }
        int nsel[2];
        for (int rb_ = 0; rb_ < DSA_RB; ++rb_)
#pragma unroll
        for (int qi = 0; qi < 2; ++qi) {
            unsigned mk = 0u;
            const bool live = lane < (adm >> 5);
            if (adm <= 256) { mk = live ? 0xffffffffu : 0u; }
            else {
                const LAS unsigned char* sp = mysc + qi * 5120 + lane * 80;
                const v4u w0 = *(const LAS v4u*)(sp), w1 = *(const LAS v4u*)(sp + 16), w2 = *(const LAS v4u*)(sp + 32), w3 = *(const LAS v4u*)(sp + 48);
                const unsigned ww[16] = {w0.x, w0.y, w0.z, w0.w, w1.x, w1.y, w1.z, w1.w, w2.x, w2.y, w2.z, w2.w, w3.x, w3.y, w3.z, w3.w};
                unsigned u[32];
#pragma unroll
                for (int i2 = 0; i2 < 16; ++i2) { typedef short s16x2 __attribute__((ext_vector_type(2)));
                    const unsigned sm = __builtin_bit_cast(unsigned, __builtin_bit_cast(s16x2, ww[i2]) >> (s16x2){15, 15});
                    const unsigned k2 = ww[i2] ^ ((sm & 0x7fff7fffu) | 0x80008000u);
                    u[2 * i2] = k2 & 0xffffu; u[2 * i2 + 1] = k2 >> 16; }
                int B1, ab1, c1, B2, ab2, c2;
                *(LAS v4u*)(hist + 4 * lane) = (v4u){0u, 0u, 0u, 0u};
                asm volatile("" ::: "memory");
                if (live) {
#pragma unroll
                    for (int i = 0; i < 32; ++i) __hip_atomic_fetch_add(hist + (u[i] >> 8), 1u, __ATOMIC_RELAXED, __HIP_MEMORY_SCOPE_WORKGROUP); }
                asm volatile("" ::: "memory");
                hist_pick(hist, lane, 256, B1, ab1, c1);
                asm volatile("" ::: "memory");
                *(LAS v4u*)(hist + 4 * lane) = (v4u){0u, 0u, 0u, 0u};
                asm volatile("" ::: "memory");
                if (live) {
#pragma unroll
                    for (int i = 0; i < 32; ++i) if ((int)(u[i] >> 8) == B1) __hip_atomic_fetch_add(hist + (u[i] & 255u), 1u, __ATOMIC_RELAXED, __HIP_MEMORY_SCOPE_WORKGROUP); }
                asm volatile("" ::: "memory");
                hist_pick(hist, lane, 256 - ab1, B2, ab2, c2);
                const unsigned T = ((unsigned)B1 << 8) | (unsigned)B2;
                const int need = 256 - ab1 - ab2;
                if (need == c2) {
#pragma unroll
                    for (int i = 0; i < 32; ++i) mk |= (u[i] >= T) ? (1u << i) : 0u;
                } else {
                    int ceq = 0;
#pragma unroll
                    for (int i = 0; i < 32; ++i) ceq += (u[i] == T) ? 1 : 0;
                    ceq = live ? ceq : 0;
                    int run = wave_prefix_incl(ceq) - ceq;
#pragma unroll
                    for (int i = 0; i < 32; ++i) { bool sel = u[i] > T; if (u[i] == T) { sel = run < need; ++run; } mk |= sel ? (1u << i) : 0u; }
                }
                if (!live) mk = 0u;
            }
            const int cnt = __popc(mk); const int incl = wave_prefix_incl(cnt);
            int off = incl - cnt; unsigned w = mk;
            while (w) { const int i = __ffs((int)w) - 1; idxl[qi * 256 + off] = (unsigned)(32 * lane + i) * 128u; ++off; w &= w - 1u; }
            nsel[qi] = __builtin_amdgcn_readlane(incl, 63);
        }
        asm volatile("" ::: "memory");
        const int vslot = lane >> 3, vch = lane & 7;
        const int ntile = nsel[0] >> 5;
        const unsigned char* Kb = (const unsigned char*)(KR + rowb * 64); const unsigned char* Vb = (const unsigned char*)(Vm + rowb * 64);
        const unsigned vofs = 16u * vch;
        bf16x8 bq[2][2]; f32x4 o[2][4]; float mref[2], lpart[2]; v4u kr[2][4], vr[2][4];
        LAS unsigned char* kbuf = F.lds + (wave < 5 ? 106496 + wave * 4608 : 132096 + (wave - 5) * 4608);
#define DSA_GATHER(T) do { _Pragma("unroll") for (int qi = 0; qi < 2; ++qi) { const LAS unsigned* il2 = idxl + qi * 256 + 32 * (T); \
            _Pragma("unroll") for (int i = 0; i < 4; ++i) { const unsigned oi = il2[vslot + 8 * i] + vofs; kr[qi][i] = *(const v4u*)(Kb + oi); vr[qi][i] = *(const v4u*)(Vb + oi); } } } while (0)
        DSA_GATHER(0);
#pragma unroll
        for (int qi = 0; qi < 2; ++qi) { const size_t qrow = rowb + qg + 2 * wave + qi;
            LAS unsigned char* qb = mysc + qi * 5120;
#pragma unroll
            for (int i = 0; i < 2; ++i) *(LAS v4u*)(qb + (8 * i + (lane >> 3)) * 144 + (lane & 7) * 16) = *(const v4u*)(Q + qrow * 1024 + i * 512 + lane * 8);
#pragma unroll
            for (int ks = 0; ks < 2; ++ks) bq[qi][ks] = *(const LAS bf16x8*)(qb + kl * 144 + g * 16 + 64 * ks);
#pragma unroll
            for (int dt = 0; dt < 4; ++dt) o[qi][dt] = (f32x4){0.f, 0.f, 0.f, 0.f};
            mref[qi] = -1e30f; lpart[qi] = 0.f; }
        asm volatile("s_waitcnt lgkmcnt(0)" ::: "memory");
        for (int tt = 0; tt < ntile; ++tt) {
            bf16x8 kc[2][4];
            unsigned onx[2][4];
#pragma unroll
            for (int qi = 0; qi < 2; ++qi)
#pragma unroll
                for (int i = 0; i < 4; ++i) onx[qi][i] = idxl[qi * 256 + 32 * min(tt + 1, ntile - 1) + vslot + 8 * i] + vofs;
            asm volatile("" ::: "memory");
#define DSA_C_TILE(GATHER) do { _Pragma("unroll") for (int qi = 0; qi < 2; ++qi) { LAS unsigned char* vbuf = mysc + qi * 5120; \
                _Pragma("unroll") for (int i = 0; i < 4; ++i) { *(LAS v4u*)(vbuf + (vslot + 8 * i) * 160 + vch * 16) = vr[qi][i]; *(LAS v4u*)(kbuf + (vslot + 8 * i) * 144 + vch * 16) = kr[qi][i]; \
                    if (GATHER) { kr[qi][i] = *(const v4u*)(Kb + onx[qi][i]); vr[qi][i] = *(const v4u*)(Vb + onx[qi][i]); } \
                    asm volatile("" ::: "memory"); } \
                _Pragma("unroll") for (int i = 0; i < 4; ++i) kc[qi][i] = *(const LAS bf16x8*)(kbuf + (kl + 16 * (i >> 1)) * 144 + g * 16 + 64 * (i & 1));     \
                asm volatile("" ::: "memory"); } } while (0)
            if (tt + 1 < ntile) DSA_C_TILE(true); else DSA_C_TILE(false);
#undef DSA_C_TILE
            f32x4 cq[4];
            asm volatile("s_nop 1\n\tv_mfma_f32_16x16x32_bf16 %0, %4, %12, 0\n\tv_mfma_f32_16x16x32_bf16 %1, %6, %12, 0\n\tv_mfma_f32_16x16x32_bf16 %2, %8, %14, 0\n\tv_mfma_f32_16x16x32_bf16 %3, %10, %14, 0\n\t"
                         "v_mfma_f32_16x16x32_bf16 %0, %5, %13, %0\n\tv_mfma_f32_16x16x32_bf16 %1, %7, %13, %1\n\tv_mfma_f32_16x16x32_bf16 %2, %9, %15, %2\n\tv_mfma_f32_16x16x32_bf16 %3, %11, %15, %3\n\ts_nop 9"
                         : "=&v"(cq[0]), "=&v"(cq[1]), "=&v"(cq[2]), "=&v"(cq[3])
                         : "v"(kc[0][0]), "v"(kc[0][1]), "v"(kc[0][2]), "v"(kc[0][3]), "v"(kc[1][0]), "v"(kc[1][1]), "v"(kc[1][2]), "v"(kc[1][3]), "v"(bq[0][0]), "v"(bq[0][1]), "v"(bq[1][0]), "v"(bq[1][1]));
            bf16x8 pb[2], vf[2][4];
#pragma unroll
            for (int qi = 0; qi < 2; ++qi) {
                float sv[8]; float tmax = -1e30f;
#pragma unroll
                for (int e = 0; e < 8; ++e) { sv[e] = e < 4 ? cq[2 * qi][e] : cq[2 * qi + 1][e - 4]; tmax = fmaxf(tmax, sv[e]); }
                if (__any(tmax > mref[qi] + 8.0f)) { float mn = fmaxf(mref[qi], tmax); mn = fmaxf(mn, __shfl_xor(mn, 16)); mn = fmaxf(mn, __shfl_xor(mn, 32));
                    const float scl = __builtin_amdgcn_exp2f(mref[qi] - mn);
#pragma unroll
                    for (int dt = 0; dt < 4; ++dt) o[qi][dt] = o[qi][dt] * scl;
                    lpart[qi] *= scl; mref[qi] = mn; }
                float p[8];
#pragma unroll
                for (int e = 0; e < 8; ++e) { p[e] = __builtin_amdgcn_exp2f(sv[e] - mref[qi]); lpart[qi] += p[e]; }
                v4u pw; pw.x = pkbf(p[0], p[1]); pw.y = pkbf(p[2], p[3]); pw.z = pkbf(p[4], p[5]); pw.w = pkbf(p[6], p[7]);
                pb[qi] = __builtin_bit_cast(bf16x8, pw);
                const LAS unsigned char* trb = mysc + qi * 5120 + (4 * g + ((lane & 15) >> 2)) * 160 + (lane & 3) * 8;
#pragma unroll
                for (int dt = 0; dt < 4; ++dt) {
                    const s16x4 va = __builtin_amdgcn_ds_read_tr16_b64_v4i16((LAS s16x4*)(trb + dt * 32));
                    const s16x4 vb = __builtin_amdgcn_ds_read_tr16_b64_v4i16((LAS s16x4*)(trb + 16 * 160 + dt * 32));
                    vf[qi][dt][0] = va[0]; vf[qi][dt][1] = va[1]; vf[qi][dt][2] = va[2]; vf[qi][dt][3] = va[3]; vf[qi][dt][4] = vb[0]; vf[qi][dt][5] = vb[1]; vf[qi][dt][6] = vb[2]; vf[qi][dt][7] = vb[3]; } }
            asm volatile("s_nop 1\n\tv_mfma_f32_16x16x32_bf16 %0, %8, %16, %0\n\tv_mfma_f32_16x16x32_bf16 %1, %9, %16, %1\n\tv_mfma_f32_16x16x32_bf16 %2, %10, %16, %2\n\tv_mfma_f32_16x16x32_bf16 %3, %11, %16, %3\n\t"
                         "v_mfma_f32_16x16x32_bf16 %4, %12, %17, %4\n\tv_mfma_f32_16x16x32_bf16 %5, %13, %17, %5\n\tv_mfma_f32_16x16x32_bf16 %6, %14, %17, %6\n\tv_mfma_f32_16x16x32_bf16 %7, %15, %17, %7\n\ts_nop 9"
                         : "+v"(o[0][0]), "+v"(o[0][1]), "+v"(o[0][2]), "+v"(o[0][3]), "+v"(o[1][0]), "+v"(o[1][1]), "+v"(o[1][2]), "+v"(o[1][3])
                         : "v"(vf[0][0]), "v"(vf[0][1]), "v"(vf[0][2]), "v"(vf[0][3]), "v"(vf[1][0]), "v"(vf[1][1]), "v"(vf[1][2]), "v"(vf[1][3]), "v"(pb[0]), "v"(pb[1]));
        }
#undef DSA_GATHER
        DSA_A_PRE(j < 7 ? j + 1 : 7);
#pragma unroll
        for (int qi = 0; qi < 2; ++qi) { const size_t qrow = rowb + qg + 2 * wave + qi;
            float l = lpart[qi]; l += __shfl_xor(l, 16); l += __shfl_xor(l, 32);
            const float inv = 1.0f / l;
            LAS unsigned char* ob = mysc + qi * 5120;
#pragma unroll
            for (int dt = 0; dt < 4; ++dt) { u32x2 w2; w2.x = pkbf(o[qi][dt][0] * inv, o[qi][dt][1] * inv); w2.y = pkbf(o[qi][dt][2] * inv, o[qi][dt][3] * inv);
                *(LAS u32x2*)(ob + kl * 128 + (16 * dt + 4 * g) * 2) = w2; }
#pragma unroll
            for (int i = 0; i < 2; ++i) *(v4u*)(ATT + qrow * 1024 + i * 512 + lane * 8) = *(const LAS v4u*)(ob + i * 1024 + lane * 16); }
    }
}


constexpr size_t CK_BK = 304 * MiB, CK_APP = 368 * MiB, CK_RPP = 400 * MiB, CK_VP = 432 * MiB, CK_W1 = 464 * MiB, CK_PC = 496 * MiB;
constexpr size_t CK_Y0 = 32 * MiB;
constexpr size_t WS_END2 = 512 * MiB;

__device__ __forceinline__ void mtx_n(const f32x4 M0, const f32x4 X0, const f32x4 a0, f32x4& r0) {
    f32x4 d0 = a0;
    asm volatile("s_nop 1\n\tv_mfma_f32_16x16x4_f32 %0, %1, %5, %0\n\tv_mfma_f32_16x16x4_f32 %0, %2, %6, %0\n\tv_mfma_f32_16x16x4_f32 %0, %3, %7, %0\n\tv_mfma_f32_16x16x4_f32 %0, %4, %8, %0\n\ts_nop 13"
                 : "+&v"(d0) : "v"(M0[0]), "v"(M0[1]), "v"(M0[2]), "v"(M0[3]), "v"(X0[0]), "v"(X0[1]), "v"(X0[2]), "v"(X0[3]));
    r0 = d0;
}
__device__ __forceinline__ void mtx_zz(const f32x4 M0, const f32x4 X0, f32x4& r0, const f32x4 M1, const f32x4 X1, f32x4& r1) {
    f32x4 d0; f32x4 d1;
    asm volatile("s_nop 1\n\tv_mfma_f32_16x16x4_f32 %0, %2, %6, 0\n\tv_mfma_f32_16x16x4_f32 %1, %10, %14, 0\n\tv_mfma_f32_16x16x4_f32 %0, %3, %7, %0\n\tv_mfma_f32_16x16x4_f32 %1, %11, %15, %1\n\tv_mfma_f32_16x16x4_f32 %0, %4, %8, %0\n\tv_mfma_f32_16x16x4_f32 %1, %12, %16, %1\n\tv_mfma_f32_16x16x4_f32 %0, %5, %9, %0\n\tv_mfma_f32_16x16x4_f32 %1, %13, %17, %1\n\ts_nop 13"
                 : "=&v"(d0), "=&v"(d1) : "v"(M0[0]), "v"(M0[1]), "v"(M0[2]), "v"(M0[3]), "v"(X0[0]), "v"(X0[1]), "v"(X0[2]), "v"(X0[3]), "v"(M1[0]), "v"(M1[1]), "v"(M1[2]), "v"(M1[3]), "v"(X1[0]), "v"(X1[1]), "v"(X1[2]), "v"(X1[3]));
    r0 = d0; r1 = d1;
}
__device__ __forceinline__ void mtx_nn(const f32x4 M0, const f32x4 X0, const f32x4 a0, f32x4& r0, const f32x4 M1, const f32x4 X1, const f32x4 a1, f32x4& r1) {
    f32x4 d0 = a0; f32x4 d1 = a1;
    asm volatile("s_nop 1\n\tv_mfma_f32_16x16x4_f32 %0, %2, %6, %0\n\tv_mfma_f32_16x16x4_f32 %1, %10, %14, %1\n\tv_mfma_f32_16x16x4_f32 %0, %3, %7, %0\n\tv_mfma_f32_16x16x4_f32 %1, %11, %15, %1\n\tv_mfma_f32_16x16x4_f32 %0, %4, %8, %0\n\tv_mfma_f32_16x16x4_f32 %1, %12, %16, %1\n\tv_mfma_f32_16x16x4_f32 %0, %5, %9, %0\n\tv_mfma_f32_16x16x4_f32 %1, %13, %17, %1\n\ts_nop 13"
                 : "+&v"(d0), "+&v"(d1) : "v"(M0[0]), "v"(M0[1]), "v"(M0[2]), "v"(M0[3]), "v"(X0[0]), "v"(X0[1]), "v"(X0[2]), "v"(X0[3]), "v"(M1[0]), "v"(M1[1]), "v"(M1[2]), "v"(M1[3]), "v"(X1[0]), "v"(X1[1]), "v"(X1[2]), "v"(X1[3]));
    r0 = d0; r1 = d1;
}
__device__ __forceinline__ void mtx_zn(const f32x4 M0, const f32x4 X0, f32x4& r0, const f32x4 M1, const f32x4 X1, const f32x4 a1, f32x4& r1) {
    f32x4 d0; f32x4 d1 = a1;
    asm volatile("s_nop 1\n\tv_mfma_f32_16x16x4_f32 %0, %2, %6, 0\n\tv_mfma_f32_16x16x4_f32 %1, %10, %14, %1\n\tv_mfma_f32_16x16x4_f32 %0, %3, %7, %0\n\tv_mfma_f32_16x16x4_f32 %1, %11, %15, %1\n\tv_mfma_f32_16x16x4_f32 %0, %4, %8, %0\n\tv_mfma_f32_16x16x4_f32 %1, %12, %16, %1\n\tv_mfma_f32_16x16x4_f32 %0, %5, %9, %0\n\tv_mfma_f32_16x16x4_f32 %1, %13, %17, %1\n\ts_nop 13"
                 : "=&v"(d0), "+&v"(d1) : "v"(M0[0]), "v"(M0[1]), "v"(M0[2]), "v"(M0[3]), "v"(X0[0]), "v"(X0[1]), "v"(X0[2]), "v"(X0[3]), "v"(M1[0]), "v"(M1[1]), "v"(M1[2]), "v"(M1[3]), "v"(X1[0]), "v"(X1[1]), "v"(X1[2]), "v"(X1[3]));
    r0 = d0; r1 = d1;
}
__device__ __forceinline__ void mtx_nnz(const f32x4 M0, const f32x4 X0, const f32x4 a0, f32x4& r0, const f32x4 M1, const f32x4 X1, const f32x4 a1, f32x4& r1, const f32x4 M2, const f32x4 X2, f32x4& r2) {
    f32x4 d0 = a0; f32x4 d1 = a1; f32x4 d2;
    asm volatile("s_nop 1\n\tv_mfma_f32_16x16x4_f32 %0, %3, %7, %0\n\tv_mfma_f32_16x16x4_f32 %1, %11, %15, %1\n\tv_mfma_f32_16x16x4_f32 %2, %19, %23, 0\n\tv_mfma_f32_16x16x4_f32 %0, %4, %8, %0\n\tv_mfma_f32_16x16x4_f32 %1, %12, %16, %1\n\tv_mfma_f32_16x16x4_f32 %2, %20, %24, %2\n\tv_mfma_f32_16x16x4_f32 %0, %5, %9, %0\n\tv_mfma_f32_16x16x4_f32 %1, %13, %17, %1\n\tv_mfma_f32_16x16x4_f32 %2, %21, %25, %2\n\tv_mfma_f32_16x16x4_f32 %0, %6, %10, %0\n\tv_mfma_f32_16x16x4_f32 %1, %14, %18, %1\n\tv_mfma_f32_16x16x4_f32 %2, %22, %26, %2\n\ts_nop 13"
                 : "+&v"(d0), "+&v"(d1), "=&v"(d2) : "v"(M0[0]), "v"(M0[1]), "v"(M0[2]), "v"(M0[3]), "v"(X0[0]), "v"(X0[1]), "v"(X0[2]), "v"(X0[3]), "v"(M1[0]), "v"(M1[1]), "v"(M1[2]), "v"(M1[3]), "v"(X1[0]), "v"(X1[1]), "v"(X1[2]), "v"(X1[3]), "v"(M2[0]), "v"(M2[1]), "v"(M2[2]), "v"(M2[3]), "v"(X2[0]), "v"(X2[1]), "v"(X2[2]), "v"(X2[3]));
    r0 = d0; r1 = d1; r2 = d2;
}
__device__ __forceinline__ void mtx_zzz(const f32x4 M0, const f32x4 X0, f32x4& r0, const f32x4 M1, const f32x4 X1, f32x4& r1, const f32x4 M2, const f32x4 X2, f32x4& r2) {
    f32x4 d0; f32x4 d1; f32x4 d2;
    asm volatile("s_nop 1\n\tv_mfma_f32_16x16x4_f32 %0, %3, %7, 0\n\tv_mfma_f32_16x16x4_f32 %1, %11, %15, 0\n\tv_mfma_f32_16x16x4_f32 %2, %19, %23, 0\n\tv_mfma_f32_16x16x4_f32 %0, %4, %8, %0\n\tv_mfma_f32_16x16x4_f32 %1, %12, %16, %1\n\tv_mfma_f32_16x16x4_f32 %2, %20, %24, %2\n\tv_mfma_f32_16x16x4_f32 %0, %5, %9, %0\n\tv_mfma_f32_16x16x4_f32 %1, %13, %17, %1\n\tv_mfma_f32_16x16x4_f32 %2, %21, %25, %2\n\tv_mfma_f32_16x16x4_f32 %0, %6, %10, %0\n\tv_mfma_f32_16x16x4_f32 %1, %14, %18, %1\n\tv_mfma_f32_16x16x4_f32 %2, %22, %26, %2\n\ts_nop 13"
                 : "=&v"(d0), "=&v"(d1), "=&v"(d2) : "v"(M0[0]), "v"(M0[1]), "v"(M0[2]), "v"(M0[3]), "v"(X0[0]), "v"(X0[1]), "v"(X0[2]), "v"(X0[3]), "v"(M1[0]), "v"(M1[1]), "v"(M1[2]), "v"(M1[3]), "v"(X1[0]), "v"(X1[1]), "v"(X1[2]), "v"(X1[3]), "v"(M2[0]), "v"(M2[1]), "v"(M2[2]), "v"(M2[3]), "v"(X2[0]), "v"(X2[1]), "v"(X2[2]), "v"(X2[3]));
    r0 = d0; r1 = d1; r2 = d2;
}
#ifndef PREP_BF16
#define PREP_BF16 0
#endif
__device__ __forceinline__ bf16x8 pk4(const f32x4 v) { v4u w; w.x = pkbf(v[0], v[1]); w.y = pkbf(v[2], v[3]); w.z = 0u; w.w = 0u; return __builtin_bit_cast(bf16x8, w); }
__device__ __forceinline__ f32x4 mtxb(const bf16x8 M, const bf16x8 X, const f32x4 acc) { f32x4 d = acc;
    asm volatile("s_nop 1\n\tv_mfma_f32_16x16x32_bf16 %0, %1, %2, %0\n\ts_nop 9" : "+&v"(d) : "v"(M), "v"(X)); return d; }
__device__ __forceinline__ void mtxb2(const bf16x8 M0, const bf16x8 X0, const f32x4 a0, f32x4& r0, const bf16x8 M1, const bf16x8 X1, const f32x4 a1, f32x4& r1) { f32x4 d0 = a0, d1 = a1;
    asm volatile("s_nop 1\n\tv_mfma_f32_16x16x32_bf16 %0, %2, %3, %0\n\tv_mfma_f32_16x16x32_bf16 %1, %4, %5, %1\n\ts_nop 9" : "+&v"(d0), "+&v"(d1) : "v"(M0), "v"(X0), "v"(M1), "v"(X1)); r0 = d0; r1 = d1; }
__device__ __forceinline__ void mtxb3(const bf16x8 M0, const bf16x8 X0, const f32x4 a0, f32x4& r0, const bf16x8 M1, const bf16x8 X1, const f32x4 a1, f32x4& r1, const bf16x8 M2, const bf16x8 X2, const f32x4 a2, f32x4& r2) { f32x4 d0 = a0, d1 = a1, d2 = a2;
    asm volatile("s_nop 1\n\tv_mfma_f32_16x16x32_bf16 %0, %3, %4, %0\n\tv_mfma_f32_16x16x32_bf16 %1, %5, %6, %1\n\tv_mfma_f32_16x16x32_bf16 %2, %7, %8, %2\n\ts_nop 9" : "+&v"(d0), "+&v"(d1), "+&v"(d2) : "v"(M0), "v"(X0), "v"(M1), "v"(X1), "v"(M2), "v"(X2)); r0 = d0; r1 = d1; r2 = d2; }
__device__ __forceinline__ void unpack4(const u32x2 x, float (&o)[4]) { o[0] = bflo(x.x); o[1] = bfhi(x.x); o[2] = bflo(x.y); o[3] = bfhi(x.y); }

__device__ __forceinline__ void rwkv_chunk_prep(const Ctx& F) {
    const int lane = F.lane, cl = lane & 15, g = lane >> 4;
    LAS unsigned char* L = F.lds + F.wave * 9216;
    LAS unsigned char* LFT = L;
    LAS unsigned char* TL = F.lds + 73728 + F.wave * 4096;
    const bf16* PROJ = (const bf16*)(F.ws + WS_R1);
    unsigned char* dout = (unsigned char*)F.out; float* BONUS = (float*)(F.ws + WS_BONUS);
    const int gw = F.vcu * NWAVES + F.wave;
    const f32x4 z4 = (f32x4){0.f, 0.f, 0.f, 0.f};
    const int bq = gw >> 7, ck = gw & 127, m0 = bq * SEQ + 16 * ck;
    bf16x8 lf[4];
    { const bf16* pt = PROJ + (size_t)(m0 + cl) * IN0;
#pragma unroll
      for (int q2 = 0; q2 < 4; ++q2) { const int col = C_WD + 32 * q2 + 8 * g;
          const v4u cur = *(const v4u*)(pt + col); v4u prv;
          prv.x = (unsigned)__builtin_amdgcn_update_dpp(0, (int)cur.x, 0x111, 0xf, 0xf, false); prv.y = (unsigned)__builtin_amdgcn_update_dpp(0, (int)cur.y, 0x111, 0xf, 0xf, false);
          prv.z = (unsigned)__builtin_amdgcn_update_dpp(0, (int)cur.z, 0x111, 0xf, 0xf, false); prv.w = (unsigned)__builtin_amdgcn_update_dpp(0, (int)cur.w, 0x111, 0xf, 0xf, false);
          if (cl == 0 && (m0 & (SEQ - 1)) != 0) prv = *(const v4u*)(PROJ + (size_t)(m0 - 1) * IN0 + col);
          const f32x4 mm0 = *(const f32x4*)(F.in[I_MU] + col), mm1 = *(const f32x4*)(F.in[I_MU] + col + 4);
          float x[8], xp[8], o8[8]; unpack8(cur, x); unpack8(prv, xp);
#pragma unroll
          for (int e2 = 0; e2 < 8; ++e2) { const float sv = x[e2] + (xp[e2] - x[e2]) * (e2 < 4 ? mm0[e2] : mm1[e2 - 4]); o8[e2] = q2 < 2 ? tanhf_(sv) : sv; }
          v4u w; w.x = pkbf(o8[0], o8[1]); w.y = pkbf(o8[2], o8[3]); w.z = pkbf(o8[4], o8[5]); w.w = pkbf(o8[6], o8[7]); lf[q2] = __builtin_bit_cast(bf16x8, w); } }
    const bf16* WL = (const bf16*)(F.ws + WS_W_LORAT);
    u32x2 rq[5], kq[5], vq5[5];
    const bool row0_is_pad = (m0 & (SEQ - 1)) == 0 && g == 0;
#define PREP_RKV(H) do { _Pragma("unroll") for (int q = 0; q < 5; ++q) { const int m = m0 + 4 * g + q - 1 + ((q == 0 && row0_is_pad) ? 1 : 0); \
            const bf16* p = PROJ + (size_t)m * IN0 + (H) * 64 + 4 * cl; rq[q] = *(const u32x2*)(p + C_R); kq[q] = *(const u32x2*)(p + C_K); vq5[q] = *(const u32x2*)(p + C_V); } } while (0)
    PREP_RKV(0);
#pragma nounroll
    for (int it = 0; it < 8; ++it) {
        const int h = it, b = bq, task = (bq * 8 + h) * 128 + ck;
        const int c0 = h * 64 + 4 * cl;
        float mur[4], muk[4], muv[4], kkc[4], kac[4], rkc[4];
#pragma unroll
        for (int j = 0; j < 4; ++j) { mur[j] = F.in[I_MU][C_R + c0 + j]; muk[j] = F.in[I_MU][C_K + c0 + j]; muv[j] = F.in[I_MU][C_V + c0 + j]; kkc[j] = F.in[I_K_K][c0 + j]; kac[j] = F.in[I_K_A][c0 + j]; rkc[j] = F.in[I_R_K][c0 + j]; }
        float wdec[4][4], alp[4][4];
        {
          bf16x8 wdk[4][2], wak[4][2];
#pragma unroll
          for (int j = 0; j < 4; ++j)
#pragma unroll
              for (int ks = 0; ks < 2; ++ks) { wdk[j][ks] = *(const bf16x8*)(WL + (((h * 4 + j) * 2 + ks) * 64 + lane) * 8); wak[j][ks] = *(const bf16x8*)(WL + ((((8 + h) * 4 + j) * 2 + ks) * 64 + lane) * 8); }
          f32x4 dacc[4], aacc[4];
          asm volatile("s_nop 1\n\tv_mfma_f32_16x16x32_bf16 %0, %8, %9, 0\n\tv_mfma_f32_16x16x32_bf16 %1, %8, %11, 0\n\tv_mfma_f32_16x16x32_bf16 %2, %8, %13, 0\n\tv_mfma_f32_16x16x32_bf16 %3, %8, %15, 0\n\t"
                       "v_mfma_f32_16x16x32_bf16 %4, %17, %19, 0\n\tv_mfma_f32_16x16x32_bf16 %5, %17, %21, 0\n\tv_mfma_f32_16x16x32_bf16 %6, %17, %23, 0\n\tv_mfma_f32_16x16x32_bf16 %7, %17, %25, 0\n\t"
                       "v_mfma_f32_16x16x32_bf16 %0, %27, %10, %0\n\tv_mfma_f32_16x16x32_bf16 %1, %27, %12, %1\n\tv_mfma_f32_16x16x32_bf16 %2, %27, %14, %2\n\tv_mfma_f32_16x16x32_bf16 %3, %27, %16, %3\n\t"
                       "v_mfma_f32_16x16x32_bf16 %4, %18, %20, %4\n\tv_mfma_f32_16x16x32_bf16 %5, %18, %22, %5\n\tv_mfma_f32_16x16x32_bf16 %6, %18, %24, %6\n\tv_mfma_f32_16x16x32_bf16 %7, %18, %26, %7\n\ts_nop 9"
                       : "=&v"(dacc[0]), "=&v"(dacc[1]), "=&v"(dacc[2]), "=&v"(dacc[3]), "=&v"(aacc[0]), "=&v"(aacc[1]), "=&v"(aacc[2]), "=&v"(aacc[3])
                       : "v"(lf[0]), "v"(wdk[0][0]), "v"(wdk[0][1]), "v"(wdk[1][0]), "v"(wdk[1][1]), "v"(wdk[2][0]), "v"(wdk[2][1]), "v"(wdk[3][0]), "v"(wdk[3][1]),
                         "v"(lf[2]), "v"(lf[3]), "v"(wak[0][0]), "v"(wak[0][1]), "v"(wak[1][0]), "v"(wak[1][1]), "v"(wak[2][0]), "v"(wak[2][1]), "v"(wak[3][0]), "v"(wak[3][1]), "v"(lf[1]));
          const f32x4 w0n = *(const f32x4*)(F.in[I_W_DECAY0] + c0) * -1.4426950408889634f, abn = *(const f32x4*)(F.in[I_A_BIAS] + c0) * -1.4426950408889634f;
#pragma unroll
          for (int q = 0; q < 4; ++q)
#pragma unroll
              for (int j = 0; j < 4; ++j) {
                  const float sd = __builtin_amdgcn_rcpf(1.0f + __builtin_amdgcn_exp2f(__builtin_fmaf(dacc[j][q], -1.4426950408889634f, w0n[j])));
                  wdec[q][j] = __builtin_amdgcn_exp2f(sd * -0.8750387749796916f);
                  alp[q][j] = __builtin_amdgcn_rcpf(1.0f + __builtin_amdgcn_exp2f(__builtin_fmaf(aacc[j][q], -1.4426950408889634f, abn[j]))); } }
        float rr[5][4], kk_[5][4], vv[5][4];
#pragma unroll
        for (int q = 0; q < 5; ++q) { unpack4(rq[q], rr[q]); unpack4(kq[q], kk_[q]); unpack4(vq5[q], vv[q]); }
        if (row0_is_pad) {
#pragma unroll
            for (int j = 0; j < 4; ++j) { rr[0][j] = 0.f; kk_[0][j] = 0.f; vv[0][j] = 0.f; } }
        if (it + 1 < 8) PREP_RKV(it + 1);
        float Pinc[4][4], Pexc[4][4], PC[4];
#pragma unroll
        for (int j = 0; j < 4; ++j) { const float l0 = wdec[0][j], l1 = l0 * wdec[1][j], l2 = l1 * wdec[2][j], l3 = l2 * wdec[3][j];
            float L0, L1, L2, L3; rows_gather4(l3, L0, L1, L2, L3);
            float E = 1.0f; if (g >= 1) E *= L0; if (g >= 2) E *= L1; if (g >= 3) E *= L2;
            Pexc[0][j] = E; Pinc[0][j] = E * l0; Pexc[1][j] = Pinc[0][j]; Pinc[1][j] = E * l1; Pexc[2][j] = Pinc[1][j]; Pinc[2][j] = E * l2; Pexc[3][j] = Pinc[2][j]; Pinc[3][j] = E * l3;
            PC[j] = (L0 * L1) * (L2 * L3); }
        f32x4 At[4], Rt[4], Vv[4];
        float Bt_[4][4], Kt_[4][4];
#pragma unroll
        for (int q = 0; q < 4; ++q) {
            float kraw[4], ks[4]; float ss = 0.f, bon = 0.f;
#pragma unroll
            for (int j = 0; j < 4; ++j) { ks[j] = kk_[q + 1][j] + (kk_[q][j] - kk_[q + 1][j]) * muk[j]; kraw[j] = ks[j] * kkc[j]; ss += kraw[j] * kraw[j]; }
            ss = row16_sum(ss);
            const float inv = rsqrtf(fmaxf(ss, 1e-24f));
#pragma unroll
            for (int j = 0; j < 4; ++j) { const float rs = rr[q + 1][j] + (rr[q][j] - rr[q + 1][j]) * mur[j], vs = vv[q + 1][j] + (vv[q][j] - vv[q + 1][j]) * muv[j];
                const float kkn = kraw[j] * inv, al = alp[q][j], kmod = ks[j] * (1.0f + (al - 1.0f) * kac[j]), bvec = kkn * al;
                const float ip = __builtin_amdgcn_rcpf(Pinc[q][j]);
                At[j][q] = -kkn * Pexc[q][j]; Rt[j][q] = rs * Pinc[q][j]; Vv[j][q] = vs; Bt_[q][j] = bvec * ip; Kt_[q][j] = kmod * ip; bon += rs * kmod * rkc[j]; }
            bon = row16_sum(bon);
            if (cl == 0) BONUS[(size_t)(m0 + 4 * g + q) * 8 + h] = bon; }
#pragma unroll
        for (int q = 0; q < 4; ++q) { LAS unsigned char* rowp = L + (4 * g + q) * 144 + cl * 8;
            u32x2 w; w.x = pkbf(At[0][q], At[1][q]); w.y = pkbf(At[2][q], At[3][q]); *(LAS u32x2*)(rowp) = w;
            w.x = pkbf(Bt_[q][0], Bt_[q][1]); w.y = pkbf(Bt_[q][2], Bt_[q][3]); *(LAS u32x2*)(rowp + 2304) = w;
            w.x = pkbf(Kt_[q][0], Kt_[q][1]); w.y = pkbf(Kt_[q][2], Kt_[q][3]); *(LAS u32x2*)(rowp + 4608) = w;
            w.x = pkbf(Rt[0][q], Rt[1][q]); w.y = pkbf(Rt[2][q], Rt[3][q]); *(LAS u32x2*)(rowp + 6912) = w; }
        const size_t cidx = (size_t)task;
        { v4u* BKo = (v4u*)(F.ws + CK_BK) + cidx * 256; float* PCo = (float*)(F.ws + CK_PC) + cidx * 64;
#pragma unroll
          for (int j = 0; j < 4; ++j) { v4u bk; bk.x = pkbf(Bt_[0][j] * PC[j], Bt_[1][j] * PC[j]); bk.y = pkbf(Bt_[2][j] * PC[j], Bt_[3][j] * PC[j]);
              bk.z = pkbf(Kt_[0][j] * PC[j], Kt_[1][j] * PC[j]); bk.w = pkbf(Kt_[2][j] * PC[j], Kt_[3][j] * PC[j]); BKo[j * 64 + lane] = bk;
              if (g == 0) PCo[j * 16 + cl] = PC[j]; } }
        asm volatile("s_waitcnt lgkmcnt(0)" ::: "memory");
        f32x4 Nab, NabT, Nak, Mbr, Mkr;
        { const LAS unsigned char* rp = L + cl * 144 + g * 16;
          const bf16x8 a0 = *(const LAS bf16x8*)(rp), a1 = *(const LAS bf16x8*)(rp + 64), b0 = *(const LAS bf16x8*)(rp + 2304), b1 = *(const LAS bf16x8*)(rp + 2304 + 64),
                       k0 = *(const LAS bf16x8*)(rp + 4608), k1 = *(const LAS bf16x8*)(rp + 4608 + 64), r0 = *(const LAS bf16x8*)(rp + 6912), r1 = *(const LAS bf16x8*)(rp + 6912 + 64);
          Nab = mfma16_z(b0, a0) + mfma16_z(b1, a1);
          NabT = mfma16_z(a0, b0) + mfma16_z(a1, b1);
          Nak = mfma16_z(k0, a0) + mfma16_z(k1, a1);
          Mbr = mfma16_z(b0, r0) + mfma16_z(b1, r1);
          Mkr = mfma16_z(k0, r0) + mfma16_z(k1, r1); }
        f32x4 T, TT;
#pragma unroll
        for (int e = 0; e < 4; ++e) { const int row = 4 * g + e;
            Nab[e] = row < cl ? Nab[e] : 0.f; Nak[e] = row < cl ? Nak[e] : 0.f; Mbr[e] = row <= cl ? Mbr[e] : 0.f; Mkr[e] = row <= cl ? Mkr[e] : 0.f;
            NabT[e] = cl < row ? NabT[e] : 0.f;
            T[e] = Nab[e] + (row == cl ? 1.f : 0.f); TT[e] = NabT[e] + (row == cl ? 1.f : 0.f); }
        { f32x4 N2, N2T, T2, TT2, N4, N4T, T4, TT4, N8;
          mtx_zz(NabT, Nab, N2, Nab, NabT, N2T);
          mtx_nn(TT, N2, T, T2, N2, TT, TT, TT2);
          mtx_zz(N2T, N2, N4, N2, N2T, N4T);
          mtx_nnz(TT2, N4, T2, T4, N4, TT2, TT2, TT4, N4T, N4, N8);
          { f32x4 Tn; mtx_n(TT4, N8, T4, Tn); T = Tn; } }
        bf16* APP = (bf16*)(F.ws + CK_APP) + cidx * 1024; bf16* RPP = (bf16*)(F.ws + CK_RPP) + cidx * 1024;
        u32x2* VPo = (u32x2*)(F.ws + CK_VP) + cidx * 256; u32x2* W1o = (u32x2*)(F.ws + CK_W1) + cidx * 256; u32x2* Y0o = (u32x2*)(dout + CK_Y0) + cidx * 256;
#if PREP_BF16
        const bf16x8 Tb = pk4(T), Nakb = pk4(Nak), Mkrb = pk4(Mkr), Mbrb = pk4(Mbr);
#endif
#pragma unroll
        for (int j = 0; j < 4; ++j) {
            f32x4 App, W1T, Y0a, W1pp, Rpp;
#if PREP_BF16
            const bf16x8 vb = pk4(Vv[j]);
            mtxb3(Tb, pk4(At[j]), z4, App, Nakb, vb, z4, W1T, Mkrb, vb, z4, Y0a);
            mtxb2(Tb, pk4(W1T), z4, W1pp, Mbrb, pk4(App), Rt[j], Rpp);
            const f32x4 Y0 = mtxb(Mbrb, pk4(W1pp), Y0a);
#else
            mtx_zzz(T, At[j], App, Nak, Vv[j], W1T, Mkr, Vv[j], Y0a);
            mtx_zn(T, W1T, W1pp, Mbr, App, Rt[j], Rpp);
            f32x4 Y0; mtx_n(Mbr, W1pp, Y0a, Y0);
#endif
            const int pos = (j >> 1) * 32 + (cl >> 2) * 8 + (cl & 3) + 4 * (j & 1);
#pragma unroll
            for (int e = 0; e < 4; ++e) { *(LAS unsigned short*)(TL + ((4 * g + e) * 64 + pos) * 2) = (unsigned short)(pkbf(App[e], 0.f) & 0xffffu); *(LAS unsigned short*)(TL + 2048 + ((4 * g + e) * 64 + pos) * 2) = (unsigned short)(pkbf(Rpp[e], 0.f) & 0xffffu); }
            u32x2 w; w.x = pkbf(Vv[j][0], Vv[j][1]); w.y = pkbf(Vv[j][2], Vv[j][3]); VPo[j * 64 + lane] = w;
            w.x = pkbf(W1pp[0], W1pp[1]); w.y = pkbf(W1pp[2], W1pp[3]); W1o[j * 64 + lane] = w;
            w.x = pkbf(Y0[0], Y0[1]); w.y = pkbf(Y0[2], Y0[3]); Y0o[j * 64 + lane] = w;
        }
        asm volatile("s_waitcnt lgkmcnt(0)" ::: "memory");
        { const int rw = lane >> 3, chn = lane & 7;
#pragma unroll
          for (int hh = 0; hh < 2; ++hh) { const int row = rw + 8 * hh;
              *(v4u*)(APP + row * 64 + 8 * chn) = *(const LAS v4u*)(TL + (row * 64 + 8 * chn) * 2);
              *(v4u*)(RPP + row * 64 + 8 * chn) = *(const LAS v4u*)(TL + 2048 + (row * 64 + 8 * chn) * 2); } }
        asm volatile("s_waitcnt lgkmcnt(0)" ::: "memory");
    }
}

#undef PREP_RKV
constexpr int CKS_SLOT = 12288, CKS_RPP = 2048, CKS_BK = 4096, CKS_P8 = 8192, CKS_P9 = 9216;
#define CKS_BAR() do { asm volatile("" ::: "memory"); __builtin_amdgcn_s_barrier(); asm volatile("" ::: "memory"); } while (0)
__device__ __forceinline__ void rwkv_chunk_seq(const Ctx& F, int bh, int pair, int lru_task) {
    const int lane = F.lane, wave = F.wave, i16 = lane & 15, g = lane >> 4;
    const int b = bh >> 3, h = bh & 7;
    const unsigned char* dout = (const unsigned char*)F.out;
    const size_t cbase = (size_t)bh * 128;
    LAS unsigned char* ring = F.lds;
    if (wave < 2) {
        const int vq = 2 * pair + wave, vo = wave * 2048;
        bf16* Y = (bf16*)(F.ws + WS_XB) + (size_t)b * SEQ * 1024 + h * 64 + 4 * i16 + vq;
        f32x4 St[4];
#pragma unroll
        for (int j = 0; j < 4; ++j) St[j] = (f32x4){0.f, 0.f, 0.f, 0.f};
        for (int c = 0; c < 128; ++c) {
            CKS_BAR();
            const LAS unsigned char* slot = ring + (c & 7) * CKS_SLOT;
            const bf16x8 cap0 = *(const LAS bf16x8*)(slot + i16 * 128 + g * 16), cap1 = *(const LAS bf16x8*)(slot + i16 * 128 + 64 + g * 16);
            const bf16x8 crp0 = *(const LAS bf16x8*)(slot + CKS_RPP + i16 * 128 + g * 16), crp1 = *(const LAS bf16x8*)(slot + CKS_RPP + i16 * 128 + 64 + g * 16);
            const bf16x8 cbk0 = *(const LAS bf16x8*)(slot + CKS_BK + lane * 16), cbk1 = *(const LAS bf16x8*)(slot + CKS_BK + 1024 + lane * 16),
                         cbk2 = *(const LAS bf16x8*)(slot + CKS_BK + 2048 + lane * 16), cbk3 = *(const LAS bf16x8*)(slot + CKS_BK + 3072 + lane * 16);
            const f32x4 cpc0 = *(const LAS f32x4*)(slot + CKS_P8 + g * 16), cpc1 = *(const LAS f32x4*)(slot + CKS_P8 + 64 + g * 16),
                        cpc2 = *(const LAS f32x4*)(slot + CKS_P8 + 128 + g * 16), cpc3 = *(const LAS f32x4*)(slot + CKS_P8 + 192 + g * 16);
            const u32x2 cvp = *(const LAS u32x2*)(slot + CKS_P8 + vo + 256 + lane * 8), cw1 = *(const LAS u32x2*)(slot + CKS_P9 + vo + lane * 8), cy0 = *(const LAS u32x2*)(slot + CKS_P9 + vo + 512 + lane * 8);
            v4u s0, s1; s0.x = pkbf(St[0][0], St[0][1]); s0.y = pkbf(St[0][2], St[0][3]); s0.z = pkbf(St[1][0], St[1][1]); s0.w = pkbf(St[1][2], St[1][3]);
            s1.x = pkbf(St[2][0], St[2][1]); s1.y = pkbf(St[2][2], St[2][3]); s1.z = pkbf(St[3][0], St[3][1]); s1.w = pkbf(St[3][2], St[3][3]);
            const bf16x8 sf0 = __builtin_bit_cast(bf16x8, s0), sf1 = __builtin_bit_cast(bf16x8, s1);
            f32x4 u0, u1, y0, y1;
            asm volatile("s_nop 1\n\tv_mfma_f32_16x16x32_bf16 %0, %4, %8, 0\n\tv_mfma_f32_16x16x32_bf16 %1, %5, %9, 0\n\tv_mfma_f32_16x16x32_bf16 %2, %6, %8, 0\n\tv_mfma_f32_16x16x32_bf16 %3, %7, %9, 0\n\ts_nop 9"
                         : "=&v"(u0), "=&v"(u1), "=&v"(y0), "=&v"(y1) : "v"(cap0), "v"(cap1), "v"(crp0), "v"(crp1), "v"(sf0), "v"(sf1));
            const f32x4 UT = ((f32x4){bflo(cw1.x), bfhi(cw1.x), bflo(cw1.y), bfhi(cw1.y)} + u0) + u1;
            const f32x4 YT = ((f32x4){bflo(cy0.x), bfhi(cy0.x), bflo(cy0.y), bfhi(cy0.y)} + y0) + y1;
            v4u uv; uv.x = pkbf(UT[0], UT[1]); uv.y = pkbf(UT[2], UT[3]); uv.z = cvp.x; uv.w = cvp.y;
            const bf16x8 uvf = __builtin_bit_cast(bf16x8, uv);
            f32x4 d0, d1, d2, d3;
            asm volatile("s_nop 1\n\tv_mfma_f32_16x16x32_bf16 %0, %4, %8, 0\n\tv_mfma_f32_16x16x32_bf16 %1, %5, %8, 0\n\tv_mfma_f32_16x16x32_bf16 %2, %6, %8, 0\n\tv_mfma_f32_16x16x32_bf16 %3, %7, %8, 0\n\ts_nop 9"
                         : "=&v"(d0), "=&v"(d1), "=&v"(d2), "=&v"(d3) : "v"(cbk0), "v"(cbk1), "v"(cbk2), "v"(cbk3), "v"(uvf));
            St[0] = St[0] * cpc0 + d0; St[1] = St[1] * cpc1 + d1; St[2] = St[2] * cpc2 + d2; St[3] = St[3] * cpc3 + d3;
#pragma unroll
            for (int e = 0; e < 4; ++e) Y[(size_t)(16 * c + 4 * g + e) * 1024] = (bf16)(pkbf(YT[e], 0.f) & 0xffffu);
        }
    } else if (wave <= 5) {
        const int kk = wave - 2;
        const unsigned char* gAPP = F.ws + CK_APP + cbase * 2048 + lane * 16; const unsigned char* gRPP = F.ws + CK_RPP + cbase * 2048 + lane * 16;
        const unsigned char* gBK = F.ws + CK_BK + cbase * 4096 + lane * 16;
        const unsigned char* gPC = F.ws + CK_PC + cbase * 256; const unsigned char* gVP = F.ws + CK_VP + cbase * 2048 + pair * 1024;
        const unsigned char* gW1 = F.ws + CK_W1 + cbase * 2048 + pair * 1024; const unsigned char* gY0 = dout + CK_Y0 + cbase * 2048 + pair * 1024;
        const unsigned char* g8 = lane < 16 ? gPC + lane * 16 : (lane < 48 ? gVP + (lane - 16) * 16 : gPC); const size_t st8 = (lane >= 16 && lane < 48) ? 2048 : 256;
        const unsigned char* g9 = lane < 32 ? gW1 + lane * 16 : gY0 + (lane - 32) * 16;
        const unsigned char* g10 = (lane >= 16 && lane < 48) ? gVP + 512 + (lane - 16) * 16 : gPC; const size_t st10 = (lane >= 16 && lane < 48) ? 2048 : 256;
        const unsigned char* g11 = lane < 32 ? gW1 + 512 + lane * 16 : gY0 + 512 + (lane - 32) * 16;
        v4u r[12];
#define CKS_LOAD(c) do { const size_t c2 = (size_t)(c) * 2048, c4 = (size_t)(c) * 4096; \
        r[0] = *(const v4u*)(gAPP + c2); r[1] = *(const v4u*)(gAPP + c2 + 1024); r[2] = *(const v4u*)(gRPP + c2); r[3] = *(const v4u*)(gRPP + c2 + 1024); \
        r[4] = *(const v4u*)(gBK + c4); r[5] = *(const v4u*)(gBK + c4 + 1024); r[6] = *(const v4u*)(gBK + c4 + 2048); r[7] = *(const v4u*)(gBK + c4 + 3072); \
        r[8] = *(const v4u*)(g8 + (size_t)(c) * st8); r[9] = *(const v4u*)(g9 + c2); r[10] = *(const v4u*)(g10 + (size_t)(c) * st10); r[11] = *(const v4u*)(g11 + c2); } while (0)
        CKS_LOAD(kk);
        for (int c = 0; c < 128; ++c) {
            if ((c & 3) == kk) { LAS unsigned char* slot = ring + (c & 7) * CKS_SLOT + lane * 16;
#pragma unroll
                for (int i = 0; i < 12; ++i) *(LAS v4u*)(slot + i * 1024) = r[i];
                asm volatile("s_waitcnt lgkmcnt(0)" ::: "memory"); }
            CKS_BAR();
            if ((c & 3) == kk && c + 4 < 128) CKS_LOAD(c + 4);
        }
#undef CKS_LOAD
    } else if (wave == 7 && lru_task >= 0) {
        const int lb = lru_task >> 3, lc = (lru_task & 7) * 64 + lane;
        const float* PS = (const float*)(F.ws + WS_LRUPS) + (size_t)lb * 128 * 1024 + lc; float* HIN = (float*)(F.ws + WS_HIN) + (size_t)lb * 128 * 512 + lc;
        float hst = 0.f; float p = PS[0], s = PS[512];
        for (int c = 0; c < 128; ++c) {
            const int cn = c + 1 < 128 ? c + 1 : c; const float np = PS[(size_t)cn * 1024], ns = PS[(size_t)cn * 1024 + 512];
            HIN[(size_t)c * 512] = hst; hst = p * hst + s;
            CKS_BAR();
            p = np; s = ns;
        }
    } else {
        for (int c = 0; c < 128; ++c) CKS_BAR();
    }
}

#ifndef P2_RR
#define P2_RR 1
#define P2_RL 1
#endif
__device__ __forceinline__ void p2_token_local(const Ctx& F) {
    const int lane = F.lane, tl = lane & 15, g = lane >> 4;
    const int gw = F.vcu * NWAVES + F.wave, NGW = F.G * NWAVES;
    const bf16* PROJ = (const bf16*)(F.ws + WS_R1);
    const bf16* WL = (const bf16*)(F.ws + WS_W_LORAT); const bf16* WG = (const bf16*)(F.ws + WS_W_GATET);
    bf16* Gg = (bf16*)((unsigned char*)F.out + DO_G);
    bf16* LRUA1 = (bf16*)((unsigned char*)F.out + DO_LRUA1); bf16* LRUX = (bf16*)((unsigned char*)F.out + DO_LRUX);
    const float* mu = F.in[I_MU]; const float* LAMSP = (const float*)(F.ws + WS_ROPE + 512 * 1024);
    LAS unsigned char* LW = F.lds + F.wave * 16384;
    LAS unsigned char* LFT = LW;
    LAS unsigned char* CVT = LW + 4864;
    LAS unsigned char* OST = LW + 10496;
    const int r8 = lane >> 3, pc8 = lane & 7;
    LAS float* CT = (LAS float*)(F.lds + EPI_LDS_OFF);
    for (int i = F.tid; i < 8 * 512; i += NWAVES * 64) { const int kind = i >> 9, c = i & 511;
        CT[i] = kind < 4 ? F.in[I_CONV_W][kind * 512 + c] : (kind == 4 ? F.in[I_CONV_B][c] : (kind == 5 ? F.in[I_B_RGATE][c] : (kind == 6 ? F.in[I_B_IGATE][c] : LAMSP[c]))); }
    __syncthreads();
    for (int tile = gw; tile < MTOK / 16; tile += NGW) {
        const int m0 = tile * 16, m = m0 + tl, t = m & (SEQ - 1), t0 = m0 & (SEQ - 1);
        const bf16* p = PROJ + (size_t)m * IN0;
        v4u cv[3];
#define P2_CVLOAD(H) do { _Pragma("unroll") for (int i = 0; i < 3; ++i) { const int row = r8 + 8 * i; const bool pad = (t0 == 0 && row < 3) || row >= 19;     \
            const int ra = (t0 == 0 && row < 3) ? 3 : (row < 19 ? row : 18);                           \
            const v4u vld = *(const v4u*)(PROJ + (size_t)(m0 + ra - 3) * IN0 + C_LX + 64 * (H) + 8 * pc8); cv[i] = pad ? (v4u){0u, 0u, 0u, 0u} : vld; } } while (0)
        P2_CVLOAD(0);
        { const int r4 = lane >> 4, pc = lane & 15;
#pragma unroll
          for (int i = 0; i < 5; ++i) { const int row = r4 + 4 * i; v4u v = (v4u){0u, 0u, 0u, 0u};
              if (row < 17 && (row > 0 || t0 > 0)) v = *(const v4u*)(PROJ + (size_t)(m0 + row - 1) * IN0 + C_WD + 128 + 8 * pc);
              if (row < 17) *(LAS v4u*)(LFT + row * 272 + pc * 16) = v; } }
        asm volatile("" ::: "memory");
        bf16x8 lf[4];
#pragma unroll
        for (int q = 4; q < 8; ++q) { const int col = C_WD + 32 * q + 8 * g;
            const v4u cur = *(const LAS v4u*)(LFT + (tl + 1) * 272 + (32 * (q - 4) + 8 * g) * 2), prv = *(const LAS v4u*)(LFT + tl * 272 + (32 * (q - 4) + 8 * g) * 2);
            const f32x4 m0 = *(const f32x4*)(mu + col), m1 = *(const f32x4*)(mu + col + 4);
            float x[8], xp[8], o[8]; unpack8(cur, x); unpack8(prv, xp);
#pragma unroll
            for (int e = 0; e < 8; ++e) { const float s = x[e] + (xp[e] - x[e]) * (e < 4 ? m0[e] : m1[e - 4]); o[e] = sigmoidf_(s); }
            v4u w; w.x = pkbf(o[0], o[1]); w.y = pkbf(o[2], o[3]); w.z = pkbf(o[4], o[5]); w.w = pkbf(o[6], o[7]); lf[q - 4] = __builtin_bit_cast(bf16x8, w); }
        bf16x8 wg_[4][4];
#define P2_WGLOAD(GRP) do { _Pragma("unroll") for (int ct = 0; ct < 4; ++ct) _Pragma("unroll") for (int ks = 0; ks < 4; ++ks) wg_[ct][ks] = *(const bf16x8*)(WL + 65536 + (((GRP) * 4 + ct) * 4 + ks) * 512 + lane * 8); } while (0)
        P2_WGLOAD(0);
#pragma nounroll
        for (int grp = 0; grp < 8; ++grp) {
            { f32x4 acc[4];
              asm volatile("s_nop 1\n\tv_mfma_f32_16x16x32_bf16 %0, %4, %20, 0\n\tv_mfma_f32_16x16x32_bf16 %1, %8, %20, 0\n\tv_mfma_f32_16x16x32_bf16 %2, %12, %20, 0\n\tv_mfma_f32_16x16x32_bf16 %3, %16, %20, 0\n\tv_mfma_f32_16x16x32_bf16 %0, %5, %21, %0\n\tv_mfma_f32_16x16x32_bf16 %1, %9, %21, %1\n\tv_mfma_f32_16x16x32_bf16 %2, %13, %21, %2\n\tv_mfma_f32_16x16x32_bf16 %3, %17, %21, %3\n\tv_mfma_f32_16x16x32_bf16 %0, %6, %22, %0\n\tv_mfma_f32_16x16x32_bf16 %1, %10, %22, %1\n\tv_mfma_f32_16x16x32_bf16 %2, %14, %22, %2\n\tv_mfma_f32_16x16x32_bf16 %3, %18, %22, %3\n\tv_mfma_f32_16x16x32_bf16 %0, %7, %23, %0\n\tv_mfma_f32_16x16x32_bf16 %1, %11, %23, %1\n\tv_mfma_f32_16x16x32_bf16 %2, %15, %23, %2\n\tv_mfma_f32_16x16x32_bf16 %3, %19, %23, %3\n\ts_nop 9"
                  : "=&v"(acc[0]), "=&v"(acc[1]), "=&v"(acc[2]), "=&v"(acc[3])
                  : "v"(wg_[0][0]), "v"(wg_[0][1]), "v"(wg_[0][2]), "v"(wg_[0][3]), "v"(wg_[1][0]), "v"(wg_[1][1]), "v"(wg_[1][2]), "v"(wg_[1][3]), "v"(wg_[2][0]), "v"(wg_[2][1]), "v"(wg_[2][2]), "v"(wg_[2][3]), "v"(wg_[3][0]), "v"(wg_[3][1]), "v"(wg_[3][2]), "v"(wg_[3][3]), "v"(lf[0]), "v"(lf[1]), "v"(lf[2]), "v"(lf[3]));
              P2_WGLOAD(grp < 7 ? grp + 1 : 7);
#pragma unroll
              for (int ct = 0; ct < 4; ++ct) { u32x2 w; w.x = pkbf(acc[ct][0], acc[ct][1]); w.y = pkbf(acc[ct][2], acc[ct][3]); *(LAS u32x2*)(OST + tl * 144 + (16 * ct + 4 * g) * 2) = w; }
              asm volatile("" ::: "memory");
#pragma unroll
              for (int i = 0; i < 2; ++i) { const int row = r8 + 8 * i; *(v4u*)(Gg + (size_t)(m0 + row) * 512 + 64 * grp + 8 * pc8) = *(const LAS v4u*)(OST + row * 144 + pc8 * 16); }
              asm volatile("" ::: "memory"); }
        }
#pragma nounroll
        for (int h = 0; h < 8; ++h) {
            bf16x8 wa[8][2]; f32x4 acc[8];
#pragma unroll
            for (int ct = 0; ct < 4; ++ct)
#pragma unroll
                for (int ks = 0; ks < 2; ++ks) { wa[ct][ks] = *(const bf16x8*)(WG + (((h * 2) * 4 + ct) * 2 + ks) * 512 + lane * 8); wa[4 + ct][ks] = *(const bf16x8*)(WG + (((h * 2 + 1) * 4 + ct) * 2 + ks) * 512 + lane * 8); }
#pragma unroll
            for (int i = 0; i < 3; ++i) { const int row = r8 + 8 * i; if (row < 19) *(LAS v4u*)(CVT + row * 144 + pc8 * 16) = cv[i]; }
            asm volatile("" ::: "memory");
            P2_CVLOAD(h < 7 ? h + 1 : 7);
            f32x4 xc_[4];
#pragma unroll
            for (int ct = 0; ct < 4; ++ct) { const int ch = 64 * h + 16 * ct + 4 * g;
                f32x4 xc = *(const LAS f32x4*)(CT + 4 * 512 + ch);
#pragma unroll
                for (int j = 0; j < 4; ++j) { const u32x2 x = *(const LAS u32x2*)(CVT + (tl + j) * 144 + (16 * ct + 4 * g) * 2); const f32x4 w4 = *(const LAS f32x4*)(CT + j * 512 + ch);
                        xc[0] += w4[0] * bflo(x.x); xc[1] += w4[1] * bfhi(x.x); xc[2] += w4[2] * bflo(x.y); xc[3] += w4[3] * bfhi(x.y); }
                xc_[ct] = xc; }
            bf16x8 xf[2];
#pragma unroll
            for (int ks = 0; ks < 2; ++ks) { v4u w; w.x = pkbf(xc_[2 * ks][0], xc_[2 * ks][1]); w.y = pkbf(xc_[2 * ks][2], xc_[2 * ks][3]); w.z = pkbf(xc_[2 * ks + 1][0], xc_[2 * ks + 1][1]); w.w = pkbf(xc_[2 * ks + 1][2], xc_[2 * ks + 1][3]);
                xf[ks] = __builtin_bit_cast(bf16x8, w); }
            asm volatile("s_nop 1\n\tv_mfma_f32_16x16x32_bf16 %0, %8, %24, 0\n\tv_mfma_f32_16x16x32_bf16 %1, %10, %24, 0\n\tv_mfma_f32_16x16x32_bf16 %2, %12, %24, 0\n\tv_mfma_f32_16x16x32_bf16 %3, %14, %24, 0\n\tv_mfma_f32_16x16x32_bf16 %4, %16, %24, 0\n\tv_mfma_f32_16x16x32_bf16 %5, %18, %24, 0\n\tv_mfma_f32_16x16x32_bf16 %6, %20, %24, 0\n\tv_mfma_f32_16x16x32_bf16 %7, %22, %24, 0\n\tv_mfma_f32_16x16x32_bf16 %0, %9, %25, %0\n\tv_mfma_f32_16x16x32_bf16 %1, %11, %25, %1\n\tv_mfma_f32_16x16x32_bf16 %2, %13, %25, %2\n\tv_mfma_f32_16x16x32_bf16 %3, %15, %25, %3\n\tv_mfma_f32_16x16x32_bf16 %4, %17, %25, %4\n\tv_mfma_f32_16x16x32_bf16 %5, %19, %25, %5\n\tv_mfma_f32_16x16x32_bf16 %6, %21, %25, %6\n\tv_mfma_f32_16x16x32_bf16 %7, %23, %25, %7\n\ts_nop 9"
                : "=&v"(acc[0]), "=&v"(acc[1]), "=&v"(acc[2]), "=&v"(acc[3]), "=&v"(acc[4]), "=&v"(acc[5]), "=&v"(acc[6]), "=&v"(acc[7])
                : "v"(wa[0][0]), "v"(wa[0][1]), "v"(wa[1][0]), "v"(wa[1][1]), "v"(wa[2][0]), "v"(wa[2][1]), "v"(wa[3][0]), "v"(wa[3][1]), "v"(wa[4][0]), "v"(wa[4][1]), "v"(wa[5][0]), "v"(wa[5][1]), "v"(wa[6][0]), "v"(wa[6][1]), "v"(wa[7][0]), "v"(wa[7][1]), "v"(xf[0]), "v"(xf[1]));
#pragma unroll
            for (int ct = 0; ct < 4; ++ct) { const int ch = 64 * h + 16 * ct + 4 * g; const f32x4 xc = xc_[ct], br = *(const LAS f32x4*)(CT + 5 * 512 + ch), bi = *(const LAS f32x4*)(CT + 6 * 512 + ch), sp8 = *(const LAS f32x4*)(CT + 7 * 512 + ch);
                float a1[4], xi[4];
#pragma unroll
                for (int e = 0; e < 4; ++e) { const float rg = sigmoidf_(acc[ct][e] + br[e]), ig = sigmoidf_(acc[4 + ct][e] + bi[e]);
                    const float la = sp8[e] * rg; float A = 1.0f - one_minus_exp(la), X = xc[e] * ig * __builtin_amdgcn_sqrtf(fmaxf(one_minus_exp(2.0f * la), 0.f));
                    { float Xp, Ap;
                      Xp = __builtin_bit_cast(float, __builtin_amdgcn_update_dpp(0, __builtin_bit_cast(int, X), 0x111, 0xf, 0xf, false)); Ap = __builtin_bit_cast(float, __builtin_amdgcn_update_dpp(0x3f800000, __builtin_bit_cast(int, A), 0x111, 0xf, 0xf, false)); X = A * Xp + X; A = A * Ap;
                      Xp = __builtin_bit_cast(float, __builtin_amdgcn_update_dpp(0, __builtin_bit_cast(int, X), 0x112, 0xf, 0xf, false)); Ap = __builtin_bit_cast(float, __builtin_amdgcn_update_dpp(0x3f800000, __builtin_bit_cast(int, A), 0x112, 0xf, 0xf, false)); X = A * Xp + X; A = A * Ap;
                      Xp = __builtin_bit_cast(float, __builtin_amdgcn_update_dpp(0, __builtin_bit_cast(int, X), 0x114, 0xf, 0xf, false)); Ap = __builtin_bit_cast(float, __builtin_amdgcn_update_dpp(0x3f800000, __builtin_bit_cast(int, A), 0x114, 0xf, 0xf, false)); X = A * Xp + X; A = A * Ap;
                      Xp = __builtin_bit_cast(float, __builtin_amdgcn_update_dpp(0, __builtin_bit_cast(int, X), 0x118, 0xf, 0xf, false)); Ap = __builtin_bit_cast(float, __builtin_amdgcn_update_dpp(0x3f800000, __builtin_bit_cast(int, A), 0x118, 0xf, 0xf, false)); X = A * Xp + X; A = A * Ap; }
                    a1[e] = A; xi[e] = X; }
                if (tl == 15) { float* ps = (float*)(F.ws + WS_LRUPS) + (size_t)tile * 1024 + 64 * h + 16 * ct + 4 * g;
                    *(f32x4*)ps = (f32x4){a1[0], a1[1], a1[2], a1[3]}; *(f32x4*)(ps + 512) = (f32x4){xi[0], xi[1], xi[2], xi[3]}; }
                u32x2 w; w.x = pkbf(a1[0], a1[1]); w.y = pkbf(a1[2], a1[3]); *(LAS u32x2*)(OST + tl * 144 + (16 * ct + 4 * g) * 2) = w;
                w.x = pkbf(xi[0], xi[1]); w.y = pkbf(xi[2], xi[3]); *(LAS u32x2*)(OST + 2304 + tl * 144 + (16 * ct + 4 * g) * 2) = w; }
            asm volatile("" ::: "memory");
#pragma unroll
            for (int i = 0; i < 2; ++i) { const int row = r8 + 8 * i;
                *(v4u*)(LRUA1 + (size_t)(m0 + row) * 512 + 64 * h + 8 * pc8) = *(const LAS v4u*)(OST + row * 144 + pc8 * 16);
                *(v4u*)(LRUX + (size_t)(m0 + row) * 512 + 64 * h + 8 * pc8) = *(const LAS v4u*)(OST + 2304 + row * 144 + pc8 * 16); }
            asm volatile("" ::: "memory");
        }
#undef P2_CVLOAD
#undef P2_WGLOAD
    }
}

#ifndef MK_SINGLE
#define MK_SINGLE 1
#endif
#ifndef GEMM_WGM_WIDE
#define GEMM_WGM_WIDE 4
#endif
#ifndef GEMM_WGM_NARROW
#define GEMM_WGM_NARROW 8
#endif
constexpr int N_PHASES = 13;
#ifndef REP_INIT
#define REP_INIT {1,1,1,1,1,1,1,1,1,1,1,1,1}
#endif
__device__ constexpr int kRep[N_PHASES] = REP_INIT;
struct Args { const float* in[29]; float* out; unsigned char* ws; int ph_lo, ph_hi; };
static_assert(sizeof(Args) == 29 * 8 + 8 + 8 + 8, "Args has no padding");

template <class Epi>
__device__ __forceinline__ void run_gemm(const Ctx& F, const bf16* A, const bf16* Bt, int N, int K, const Epi& E, bool b_pre = false) {
    int Kv = K; asm volatile("" : "+s"(Kv));
    pg8::Gemm g{A, Bt, MTOK, N, Kv}; pg8::StaticOrder S; S.init(MTOK, N, F.G, (int)blockIdx.x, N > 1024 ? GEMM_WGM_WIDE : GEMM_WGM_NARROW);
    pg8::gemm_phase<Epi, pg8::StaticOrder, true, true>(F.lds + RING_OFF, g, S, E, b_pre);
}
template <bool PERM>
__device__ __forceinline__ void gemm_pre(const Ctx& F, const bf16* Bt, int N, int K) {
    pg8::Gemm g{nullptr, Bt, MTOK, N, K}; pg8::StaticOrder S; S.init(MTOK, N, F.G, (int)blockIdx.x, N > 1024 ? GEMM_WGM_WIDE : GEMM_WGM_NARROW);
    pg8::gemm_prestage_b<PERM>(F.lds + RING_OFF, g, S, F.tid);
}

__global__ void __launch_bounds__(NWAVES * 64, 2) mk_fwd(Args args) {
    extern __shared__ __attribute__((aligned(16))) unsigned char lds[];
    Ctx F;
    F.lds = (LAS unsigned char*)lds;
    F.tid = threadIdx.x; F.lane = F.tid & 63; F.wave = __builtin_amdgcn_readfirstlane(F.tid >> 6);
    F.G = gridDim.x; { const int bx = blockIdx.x; F.vcu = (F.G % 8 == 0) ? (bx % 8) * (F.G / 8) + bx / 8 : bx; }
    F.in = args.in;
    F.out = args.out; F.ws = args.ws;
    unsigned char* ws = args.ws;
    for (int u = F.tid; u < (LDS_BYTES - LDSCTL_OFF) / 4; u += NWAVES * 64) ((LAS unsigned*)(F.lds + LDSCTL_OFF))[u] = 0u;
    __syncthreads();
    const int lo = args.ph_lo, hi = args.ph_hi;
    const bool multi = (hi - lo) > 1;
    XcdBarrier bar; bar.bar = (unsigned*)(ws + WS_CTL) + CW_BAR; bar.x = 0; bar.st = nullptr;
    if (multi) bar = xcd_barrier_post((unsigned*)(ws + WS_CTL) + CW_BAR, (volatile LAS unsigned*)(F.lds + MISC_OFF) + 8);
#ifndef PHASE_MASK
#define PHASE_MASK 0x1fff
#endif
#define IN(k) (((PHASE_MASK >> (k)) & 1) && lo <= (k) && (k) < hi)
#define SEAM(k) do { if (IN(k) && IN((k) + 1)) xcd_barrier(bar); } while (0)
    float* ssq = (float*)(ws + WS_SSQ);
    bf16* XB = (bf16*)(ws + WS_XB);

    int pk = 0;
#define PHASE_BEGIN if (IN(pk)) for (int rep_ = 0; rep_ < kRep[pk]; ++rep_) { Ctx Fp = F; LAS unsigned char* eb = F.lds + EPI_LDS_OFF + F.wave * EPI_LDS_WAVE; (void)eb; Fp.tid = threadIdx.x; asm volatile("" : "+v"(Fp.tid)); Fp.lane = Fp.tid & 63;
#define PHASE_END } SEAM(pk); ++pk;
#define PHASE_END_PRE(PERM, BT, N, K) } do { if (IN(pk) && IN(pk + 1)) xcd_barrier(bar, [&]() { gemm_pre<PERM>(F, (const bf16*)(ws + (BT)), N, K); }); } while (0); ++pk;
#define PRE_OK (rep_ == 0 && IN(pk - 1) && IN(pk))
    PHASE_BEGIN p0_prologue(Fp); PHASE_END
    PHASE_BEGIN EpiScaleBf16 E{(bf16*)(ws + WS_R1), IN0, ssq, eb}; run_gemm(Fp, XB, (const bf16*)(ws + WS_W_IN0T), IN0, 1024, E);
        if (rep_ == 0 && (int)blockIdx.x >= (MTOK / 256) * (IN0 / 256) % (int)gridDim.x) {
            __syncthreads(); p0_layer1_weights(Fp, ((int)blockIdx.x - (MTOK / 256) * (IN0 / 256) % (int)gridDim.x) * NWAVES + Fp.wave, ((int)gridDim.x - (MTOK / 256) * (IN0 / 256) % (int)gridDim.x) * NWAVES); }
    PHASE_END
    PHASE_BEGIN if (rep_ > 0) __syncthreads(); p2_token_local(Fp); __syncthreads(); { Ctx Fq = F; Fq.tid = threadIdx.x; asm volatile("" : "+v"(Fq.tid)); Fq.lane = Fq.tid & 63; rwkv_chunk_prep(Fq); } PHASE_END
    PHASE_BEGIN rwkv_chunk_seq(Fp, Fp.vcu >> 1, Fp.vcu & 1, (Fp.vcu & 1) ? -1 : (Fp.vcu >> 1)); PHASE_END
    PHASE_BEGIN p5_postscan(Fp); PHASE_END_PRE(true, WS_W_OUT0T, 1024, 1024)
    PHASE_BEGIN EpiResid<false> E{Fp.in[I_X], (bf16*)(ws + WS_R2), ssq, eb}; run_gemm(Fp, XB, (const bf16*)(ws + WS_W_OUT0T), 1024, 1024, E, PRE_OK); PHASE_END_PRE(true, WS_W_GU0T, 2 * FFH, 1024)
    PHASE_BEGIN EpiSwiglu E{(bf16*)(ws + WS_R1), ssq, eb}; run_gemm(Fp, (const bf16*)(ws + WS_R2), (const bf16*)(ws + WS_W_GU0T), 2 * FFH, 1024, E, PRE_OK); PHASE_END_PRE(true, WS_W_DN0T, 1024, FFH)
    PHASE_BEGIN EpiResid<true> E{(const bf16*)(ws + WS_R2), XB, ssq, eb}; run_gemm(Fp, (const bf16*)(ws + WS_R1), (const bf16*)(ws + WS_W_DN0T), 1024, FFH, E, PRE_OK); PHASE_END_PRE(false, WS_W_IN1T, IN1P, 1024)
    PHASE_BEGIN EpiProj1 E{ssq, (const unsigned char*)(ws + WS_ROPE), (bf16*)(ws + WS_Q), (bf16*)(ws + WS_KR), (bf16*)(ws + WS_VT), (bf16*)(ws + WS_IQ), (bf16*)(ws + WS_IK), (float*)(ws + WS_IW), eb};
                run_gemm(Fp, XB, (const bf16*)(ws + WS_W_IN1T), IN1P, 1024, E, PRE_OK); PHASE_END
    PHASE_BEGIN dsa_phase(Fp); PHASE_END_PRE(true, WS_W_OUT1T, 1024, 1024)
    PHASE_BEGIN EpiResid<true> E{XB, XB, ssq, eb}; run_gemm(Fp, (const bf16*)(ws + WS_R1), (const bf16*)(ws + WS_W_OUT1T), 1024, 1024, E, PRE_OK); PHASE_END_PRE(true, WS_W_GU1T, 2 * FFH, 1024)
    PHASE_BEGIN EpiSwiglu E{(bf16*)(ws + WS_R2), ssq, eb}; run_gemm(Fp, XB, (const bf16*)(ws + WS_W_GU1T), 2 * FFH, 1024, E, PRE_OK); PHASE_END_PRE(true, WS_W_DN1T, 1024, FFH)
    PHASE_BEGIN EpiResidFinal E{XB, Fp.out, Fp.in[I_NORM_FINAL], (float*)(ws + WS_XCHG), (unsigned*)(ws + WS_CTL) + CW_PANEL, eb}; run_gemm(Fp, (const bf16*)(ws + WS_R2), (const bf16*)(ws + WS_W_DN1T), 1024, FFH, E, PRE_OK); PHASE_END
#undef PHASE_BEGIN
#undef PHASE_END
#undef PHASE_END_PRE
#undef PRE_OK
#undef IN
#undef SEAM
}

extern "C" void kernel_launch(void* const* d_in, const int* in_sizes, int n_in, void* d_out, int out_size, void* d_ws, size_t ws_size, hipStream_t stream) {
    static int grid = 0;
    if (grid == 0) {
        if (n_in != 29 || in_sizes[0] != MTOK * DM || out_size != MTOK * DM || ws_size < WS_END2) {
            fprintf(stderr, "kernel_launch: unexpected shapes (n_in %d, in0 %d, out %d, ws %zu); nothing launched\n", n_in, n_in > 0 ? in_sizes[0] : -1, out_size, ws_size); grid = -1; return; }
        int dev = 0, cus = 0;
        if (hipGetDevice(&dev) != hipSuccess || hipDeviceGetAttribute(&cus, hipDeviceAttributeMultiprocessorCount, dev) != hipSuccess) { grid = -1; return; }
        if (hipFuncSetAttribute((const void*)mk_fwd, hipFuncAttributeMaxDynamicSharedMemorySize, LDS_BYTES) != hipSuccess) { fprintf(stderr, "kernel_launch: hipFuncSetAttribute failed\n"); grid = -1; return; }
        int per_cu = 0;
        if (hipOccupancyMaxActiveBlocksPerMultiprocessor(&per_cu, (const void*)mk_fwd, NWAVES * 64, LDS_BYTES) != hipSuccess || per_cu < 1)
            fprintf(stderr, "kernel_launch: note: occupancy query reports %d workgroups per CU\n", per_cu);
        (void)hipGetLastError();
        grid = cus;
        if (grid != 256) { fprintf(stderr, "kernel_launch: this kernel needs a 256-CU device (got %d)\n", grid); grid = -1; return; }
    }
    if (grid < 0) return;
    if (hipMemsetAsync((char*)d_ws + WS_CTL, 0, CTL_ZERO_BYTES, stream) != hipSuccess) { fprintf(stderr, "kernel_launch: memset failed\n"); return; }
    Args a{};
    for (int i = 0; i < 29; ++i) a.in[i] = (const float*)d_in[i];
    a.out = (float*)d_out; a.ws = (unsigned char*)d_ws;
#if MK_SINGLE
    a.ph_lo = 0; a.ph_hi = N_PHASES;
    hipLaunchKernelGGL(mk_fwd, dim3(grid), dim3(NWAVES * 64), LDS_BYTES, stream, a);
#else
    for (int p = 0; p < N_PHASES; ++p) { a.ph_lo = p; a.ph_hi = p + 1; hipLaunchKernelGGL(mk_fwd, dim3(grid), dim3(NWAVES * 64), LDS_BYTES, stream, a); }
#endif
}
```
